# Optimizing an MI355X kernel written in HIP

```python
import jax, jax.numpy as jnp
from jax import lax
import numpy as np

D_MODEL = 1024
BATCH = 16
SEQ = 4096
DEPTH = 4

GRID_W = 64
CTX_LEN = 256
EPS = 1e-6

POOL_W = 256
POOL_GROUPS = 4
POOL_GC = POOL_W // POOL_GROUPS
POOL_WINDOWS = (2, 4, 8, 16)
MLA_HEADS = 8
MLA_NOPE = 64
MLA_ROPE = 32
MLA_V = 64
MLA_QK = MLA_NOPE + MLA_ROPE
Q_LORA = 256
KV_LORA = 128
Q_BLOCK = 128
ROPE_THETA = 10000.0
GLA_HEADS = 4
GLA_DK = 32
GLA_DV = 64
GLA_GATE_RANK = 16
GLA_GATE_NORM = 16.0
GLA_CHUNK = 64
MIX_W = POOL_W + MLA_HEADS * MLA_V + GLA_HEADS * GLA_DV
D_FF = 2816
CONV_W = 3

KEY_SIZES = (KV_LORA, MLA_ROPE, GLA_HEADS * GLA_DK, GLA_HEADS * GLA_DV, GLA_GATE_RANK, GLA_GATE_RANK)
QUERY_SIZES = (POOL_W, Q_LORA, GLA_HEADS * GLA_DK, GLA_HEADS * GLA_DV)
KEY_COLS = sum(KEY_SIZES)
IN_COLS = KEY_COLS + sum(QUERY_SIZES)

kernel_name = "hybrid_pool_mla_gla_diffusion_trunk"


def split_cols(z, sizes):
    out, o = [], 0
    for s in sizes:
        out.append(z[..., o:o + s])
        o += s
    return out


def rmsnorm(x, g):
    xf = x.astype(jnp.float32)
    y = xf * lax.rsqrt(jnp.mean(xf * xf, axis=-1, keepdims=True) + EPS)
    return y.astype(x.dtype) * g


def modulate(h, shift, scale):
    return h * (1.0 + scale) + shift


def rope_2d_tables(L):
    rows = L // GRID_W
    row = jnp.repeat(jnp.arange(rows), GRID_W).astype(jnp.float32)
    col = jnp.tile(jnp.arange(GRID_W), rows).astype(jnp.float32)
    half = MLA_ROPE // 2
    inv = ROPE_THETA ** (-jnp.arange(0, half, 2, dtype=jnp.float32) / half)
    ar = row[:, None] * inv
    ac = col[:, None] * inv
    ang = jnp.concatenate([ar, ar, ac, ac], axis=-1)
    return jnp.cos(ang), jnp.sin(ang)


def apply_rope(x, cos, sin):
    xf = x.astype(jnp.float32)
    xr = xf.reshape(xf.shape[:-1] + (2, 2, MLA_ROPE // 4))
    rot = jnp.stack([-xr[..., 1, :], xr[..., 0, :]], axis=-2).reshape(xf.shape)
    return (xf * cos + rot * sin).astype(x.dtype)


def multiscale_pool(u, w_pool, pool_scale):
    B, L, _ = u.shape
    P = jnp.pad(jnp.cumsum(u.astype(jnp.float32), axis=1), ((0, 0), (1, 0), (0, 0)))
    t = jnp.arange(L)
    means = []
    for gi, w in enumerate(POOL_WINDOWS):
        lo = jnp.clip(t - w // 2, 0, L)
        hi = jnp.clip(t - w // 2 + w, 0, L)
        Pg = P[..., gi * POOL_GC:(gi + 1) * POOL_GC]
        s = jnp.take(Pg, hi, axis=1) - jnp.take(Pg, lo, axis=1)
        means.append(s / (hi - lo).astype(jnp.float32)[None, :, None])
    pooled = jnp.stack(means, axis=2).astype(u.dtype)
    diff = pooled - u.reshape(B, L, POOL_GROUPS, POOL_GC)
    y = jnp.einsum('blgc,gcd->blgd', diff, w_pool).reshape(B, L, POOL_W)
    return y * pool_scale


def mla_softmax(qn, qr, kn, kr, v):
    s = jnp.einsum('bqhd,bkhd->bhqk', qn, kn) + jnp.einsum('bqhr,bkr->bhqk', qr, kr)
    p = jax.nn.softmax(s.astype(jnp.float32) * (MLA_QK ** -0.5), axis=-1)
    return jnp.einsum('bhqk,bkhd->bqhd', p.astype(v.dtype), v)


def mla_blockwise(qn, qr, kn, kr, v):
    B, L = qn.shape[:2]
    nb = L // Q_BLOCK
    to_blocks = lambda a: a.reshape((B, nb, Q_BLOCK) + a.shape[2:]).swapaxes(0, 1)
    out = lax.map(lambda qs: mla_softmax(qs[0], qs[1], kn, kr, v), (to_blocks(qn), to_blocks(qr)))
    return out.swapaxes(0, 1).reshape(B, L, MLA_HEADS, MLA_V)


def gla_gate(lr, w, b):
    B, L, _ = lr.shape
    g = jax.nn.log_sigmoid((lr @ w + b).astype(jnp.float32)) / GLA_GATE_NORM
    return g.reshape(B, L, GLA_HEADS, GLA_DK)


def gla_scan(k, v, g, s0, q=None):
    B, L, H, _ = k.shape
    n = L // GLA_CHUNK
    chunks = lambda a: a.astype(jnp.float32).reshape(B, n, GLA_CHUNK, H, a.shape[-1])
    kc, vc = chunks(k), chunks(v)
    b = jnp.cumsum(chunks(g), axis=2)
    b_last = b[:, :, -1:]
    kv = jnp.einsum('bnchd,bnchv->nbhdv', kc * jnp.exp(b_last - b), vc)
    decay = jnp.exp(b_last[:, :, 0]).swapaxes(0, 1)

    def step(s, inp):
        d, kvn = inp
        return d[..., None] * s + kvn, s

    s_fin, s_in = lax.scan(step, s0, (decay, kv))
    if q is None:
        return None, s_fin
    qc = chunks(q) * (GLA_DK ** -0.5)
    mid = b[:, :, GLA_CHUNK // 2:GLA_CHUNK // 2 + 1]
    tri = jnp.tril(jnp.ones((GLA_CHUNK, GLA_CHUNK), jnp.float32))
    att = jnp.einsum('bnihd,bnjhd->bnhij', qc * jnp.exp(b - mid), kc * jnp.exp(mid - b)) * tri
    o = (jnp.einsum('bnhij,bnjhv->bnihv', att, vc)
         + jnp.einsum('bnihd,nbhdv->bnihv', qc * jnp.exp(b), s_in))
    return o.reshape(B, L, H, GLA_DV).astype(v.dtype), s_fin


def token_mix(h_l, h_c, w_in, q_norm, w_uq, kv_norm, w_ukv, w_gk_f, b_gk_f, w_gk_b, b_gk_b,
              gla_norm, w_pool, pool_scale, cos, sin, ctx_out):
    B, L, _ = h_l.shape
    Lc = h_c.shape[1]
    flip = lambda a: a[:, ::-1]
    z_l = h_l @ w_in
    z_c = h_c @ (w_in if ctx_out else w_in[:, :KEY_COLS])
    ckv_l, kr_l, gk_l, gv_l, lrf_l, lrb_l, pool_l, cq_l, gq_l, og_l = split_cols(z_l, KEY_SIZES + QUERY_SIZES)
    ckv_c, kr_c, gk_c, gv_c, lrf_c, lrb_c = split_cols(z_c[..., :KEY_COLS], KEY_SIZES)

    def mla_kv(ckv):
        ukv = (rmsnorm(ckv, kv_norm) @ w_ukv).reshape(B, -1, MLA_HEADS, MLA_NOPE + MLA_V)
        return ukv[..., :MLA_NOPE], ukv[..., MLA_NOPE:]

    def mla_q(cq):
        uq = (rmsnorm(cq, q_norm) @ w_uq).reshape(B, -1, MLA_HEADS, MLA_QK)
        return uq[..., :MLA_NOPE], uq[..., MLA_NOPE:]

    kn_l, v_l = mla_kv(ckv_l)
    kn_c, v_c = mla_kv(ckv_c)
    kr_l = apply_rope(kr_l, cos, sin)
    kn_all = jnp.concatenate([kn_c, kn_l], axis=1)
    kr_all = jnp.concatenate([kr_c, kr_l], axis=1)
    v_all = jnp.concatenate([v_c, v_l], axis=1)
    qn_l, qr_l = mla_q(cq_l)
    qr_l = apply_rope(qr_l, cos[:, None, :], sin[:, None, :])
    att_l = mla_blockwise(qn_l, qr_l, kn_all, kr_all, v_all).reshape(B, L, MLA_HEADS * MLA_V)

    heads = lambda a, d: a.reshape(a.shape[0], a.shape[1], GLA_HEADS, d)
    s_zero = jnp.zeros((B, GLA_HEADS, GLA_DK, GLA_DV), jnp.float32)
    gq_c = heads(split_cols(z_c[..., KEY_COLS:], QUERY_SIZES)[2], GLA_DK) if ctx_out else None
    kc_, vc_ = heads(gk_c, GLA_DK), heads(gv_c, GLA_DV)
    o_cf, s_cf = gla_scan(kc_, vc_, gla_gate(lrf_c, w_gk_f, b_gk_f), s_zero, gq_c)
    o_cb, s_cb = gla_scan(flip(kc_), flip(vc_), flip(gla_gate(lrb_c, w_gk_b, b_gk_b)), s_zero,
                          None if gq_c is None else flip(gq_c))
    ql_, kl_, vl_ = heads(gq_l, GLA_DK), heads(gk_l, GLA_DK), heads(gv_l, GLA_DV)
    o_lf, _ = gla_scan(kl_, vl_, gla_gate(lrf_l, w_gk_f, b_gk_f), s_cf, ql_)
    o_lb, _ = gla_scan(flip(kl_), flip(vl_), flip(gla_gate(lrb_l, w_gk_b, b_gk_b)), s_cb, flip(ql_))

    def gla_out(o, og):
        y = rmsnorm(o, gla_norm) * jax.nn.silu(heads(og, GLA_DV))
        return y.reshape(y.shape[0], y.shape[1], GLA_HEADS * GLA_DV)

    gla_l = gla_out(o_lf + flip(o_lb), og_l)
    y_l = jnp.concatenate([multiscale_pool(pool_l, w_pool, pool_scale), att_l, gla_l], axis=-1)
    if not ctx_out:
        return y_l, None

    pool_c, cq_c, _, og_c = split_cols(z_c[..., KEY_COLS:], QUERY_SIZES)
    qn_c, qr_c = mla_q(cq_c)
    att_c = mla_softmax(qn_c, qr_c, kn_c, kr_c, v_c).reshape(B, Lc, MLA_HEADS * MLA_V)
    gla_c = gla_out(o_cf + flip(o_cb), og_c)
    y_c = jnp.concatenate([multiscale_pool(pool_c, w_pool, pool_scale), att_c, gla_c], axis=-1)
    return y_l, y_c


def conv_ffn(h, w_up, conv_w, conv_b, w_down):
    u, g = split_cols(h @ w_up, (D_FF, D_FF))
    gp = jnp.pad(g, ((0, 0), (1, 1), (0, 0)))
    g = gp[:, :-2] * conv_w[0] + gp[:, 1:-1] * conv_w[1] + gp[:, 2:] * conv_w[2] + conv_b
    return (jax.nn.silu(g) * u) @ w_down


def setup_inputs(seed: int = 0) -> dict:
    key = jax.random.key(seed)
    ks = jax.random.split(key, 32)
    nrm = lambda k, shape, scale: jax.random.normal(k, shape, jnp.float32) * scale
    gain = lambda k, shape: 1.0 + nrm(k, shape, 0.05)
    D, L = DEPTH, D_MODEL
    return {
        "x": nrm(ks[0], (BATCH, SEQ, D_MODEL), 1.0),
        "c": nrm(ks[1], (BATCH, D_MODEL), 1.0),
        "ctx": nrm(ks[2], (BATCH, CTX_LEN, D_MODEL), 1.0),
        "c_ctx": nrm(ks[3], (D_MODEL,), 1.0),
        "w_ada": nrm(ks[4], (D, D_MODEL, 6 * D_MODEL), 0.1 * D_MODEL ** -0.5),
        "b_ada": nrm(ks[5], (D, 6 * D_MODEL), 0.02),
        "norm1": gain(ks[6], (D, D_MODEL)),
        "norm2": gain(ks[7], (D, D_MODEL)),
        "w_in": nrm(ks[8], (D, D_MODEL, IN_COLS), D_MODEL ** -0.5),
        "q_norm": gain(ks[9], (D, Q_LORA)),
        "w_uq": nrm(ks[10], (D, Q_LORA, MLA_HEADS * MLA_QK), Q_LORA ** -0.5),
        "kv_norm": gain(ks[11], (D, KV_LORA)),
        "w_ukv": nrm(ks[12], (D, KV_LORA, MLA_HEADS * (MLA_NOPE + MLA_V)), KV_LORA ** -0.5),
        "w_gk_f": nrm(ks[13], (D, GLA_GATE_RANK, GLA_HEADS * GLA_DK), GLA_GATE_RANK ** -0.5),
        "b_gk_f": nrm(ks[14], (D, GLA_HEADS * GLA_DK), 0.1),
        "w_gk_b": nrm(ks[15], (D, GLA_GATE_RANK, GLA_HEADS * GLA_DK), GLA_GATE_RANK ** -0.5),
        "b_gk_b": nrm(ks[16], (D, GLA_HEADS * GLA_DK), 0.1),
        "gla_norm": gain(ks[17], (D, GLA_DV)),
        "w_pool": nrm(ks[18], (D, POOL_GROUPS, POOL_GC, POOL_GC), POOL_GC ** -0.5),
        "pool_scale": gain(ks[19], (D, POOL_W)),
        "w_o": nrm(ks[20], (D, MIX_W, D_MODEL), MIX_W ** -0.5),
        "w_up": nrm(ks[21], (D, D_MODEL, 2 * D_FF), D_MODEL ** -0.5),
        "conv_w": nrm(ks[22], (D, CONV_W, D_FF), CONV_W ** -0.5),
        "conv_b": nrm(ks[23], (D, D_FF), 0.02),
        "w_down": nrm(ks[24], (D, D_FF, D_MODEL), D_FF ** -0.5),
        "norm_f": gain(ks[25], (D_MODEL,)),
    }


def reference(x, c, ctx, c_ctx, w_ada, b_ada, norm1, norm2, w_in, q_norm, w_uq, kv_norm, w_ukv,
              w_gk_f, b_gk_f, w_gk_b, b_gk_b, gla_norm, w_pool, pool_scale, w_o, w_up, conv_w,
              conv_b, w_down, norm_f):
    B, L, Dm = x.shape
    cos, sin = rope_2d_tables(L)
    silu_c = jax.nn.silu(c)
    silu_cc = jax.nn.silu(c_ctx)
    xc = ctx
    for i in range(DEPTH):
        last = i == DEPTH - 1
        m_l = (silu_c @ w_ada[i] + b_ada[i]).reshape(B, 1, 6, Dm)
        n_c = 2 if last else 6
        m_c = (silu_cc @ w_ada[i][:, :n_c * Dm] + b_ada[i][:n_c * Dm]).reshape(n_c, Dm)
        h_l = modulate(rmsnorm(x, norm1[i]), m_l[:, :, 0], m_l[:, :, 1])
        h_c = modulate(rmsnorm(xc, norm1[i]), m_c[0], m_c[1])
        y_l, y_c = token_mix(h_l, h_c, w_in[i], q_norm[i], w_uq[i], kv_norm[i], w_ukv[i],
                             w_gk_f[i], b_gk_f[i], w_gk_b[i], b_gk_b[i], gla_norm[i],
                             w_pool[i], pool_scale[i], cos, sin, not last)
        x = x + m_l[:, :, 2] * (y_l @ w_o[i])
        x = x + m_l[:, :, 5] * conv_ffn(modulate(rmsnorm(x, norm2[i]), m_l[:, :, 3], m_l[:, :, 4]),
                                        w_up[i], conv_w[i], conv_b[i], w_down[i])
        if not last:
            xc = xc + m_c[2] * (y_c @ w_o[i])
            xc = xc + m_c[5] * conv_ffn(modulate(rmsnorm(xc, norm2[i]), m_c[3], m_c[4]),
                                        w_up[i], conv_w[i], conv_b[i], w_down[i])
    return rmsnorm(x, norm_f)
```

```cpp
#include <hip/hip_runtime.h>
#include <hip/hip_cooperative_groups.h>
#include <cstdio>
#include <cstdint>
namespace cg = cooperative_groups;
__device__ __forceinline__ int otid() { int t = threadIdx.x; asm volatile("" : "+v"(t)); return t; }
__device__ __forceinline__ int obid() { int t = blockIdx.x; asm volatile("" : "+s"(t)); return t; }
namespace pg8 {
#define PG8_LAS __attribute__((address_space(3)))
typedef unsigned short bf16_t;
typedef short bf16x8 __attribute__((ext_vector_type(8)));
typedef float f32x4 __attribute__((ext_vector_type(4)));
typedef unsigned u32x4 __attribute__((ext_vector_type(4)));
constexpr int BM = 256, BK = 64, HALF = 128, HTB = HALF * BK * 2  , STAGE_BYTES = 8 * HTB, NXCD = 8, WGM = 8;

__host__ __device__ __forceinline__ int lds_byte(int r, int c) { const int st = (r >> 4) * 2 + (c >> 5), rr = r & 15, cc = c & 31, ob = rr * 64 + cc * 2; return st * 1024 + (ob ^ (((ob >> 9) & 1) << 5)); }
__host__ __device__ __forceinline__ void stage_rc(int b, int& R, int& C) { const int st = b / 1024, sb = b % 1024, swz = sb ^ (((sb >> 9) & 1) << 5); R = (st >> 1) * 16 + swz / 64; C = (st & 1) * 32 + (swz % 64) / 2; }
__host__ __device__ __forceinline__ int perm32(int rho) { const int n = rho >> 4, i = rho & 15; return 8 * (i >> 2) + 4 * n + (i & 3); }

struct Unit { int pm, pn; };
struct Gemm { const bf16_t* A; const bf16_t* Bt; int M, N, K, a_skip; };

struct StaticOrder {
    int nM, nN, nwg, G, c;
    __host__ __device__ void init(int M, int N, int G_, int c_) { nM = M / BM; nN = N / BM; nwg = nM * nN; G = G_; c = c_; }
    __host__ __device__ bool next(int i, Unit& u) const {
        const long L = (long)i * G + c; if (L >= nwg) return false;
        int wgid = (int)L; { const int q = nwg / NXCD, r = nwg % NXCD, xcd = wgid % NXCD, off = wgid / NXCD; wgid = (xcd < r ? xcd * (q + 1) : r * (q + 1) + (xcd - r) * q) + off; }
        const int nig = WGM * nN, gid = wgid / nig, fm = gid * WGM, gsz = (nM - fm) < WGM ? (nM - fm) : WGM;
        u.pm = fm + ((wgid % nig) % gsz); u.pn = (wgid % nig) / gsz; return true;
    }
    __device__ __forceinline__ void a_ready(const Unit&) const {}
    __device__ __forceinline__ void done(const Unit&) const {}
};

__device__ __forceinline__ unsigned cvt_pk_bf16(float lo, float hi) { unsigned r; asm volatile("v_cvt_pk_bf16_f32 %0, %1, %2" : "=v"(r) : "v"(lo), "v"(hi)); return r; }
struct EpiBf16g {
    static constexpr bool PERM = true, AFTER_DRAIN = false;
    bf16_t* O; size_t ldc; float sc; int gshift, gout;
    __device__ __forceinline__ void operator()(const f32x4 (&acc)[2][2][4][2], const Unit& u, int wr, int wc, int fr, int fq) const {
        const int row0 = u.pm * BM + wr * 64 + fr;
        const int c0 = u.pn * BM + wc * 32 + 8 * fq;
#pragma unroll
        for (int ai = 0; ai < 2; ++ai)
#pragma unroll
            for (int m = 0; m < 4; ++m) { bf16_t* rowp = O + (size_t)(row0 + ai * HALF + m * 16) * ldc;
#pragma unroll
                for (int bj = 0; bj < 2; ++bj) { const int c = c0 + bj * HALF; const int dc = (c >> gshift) * gout + (c & ((1 << gshift) - 1));
                    f32x4 v0 = acc[ai][bj][m][0] * sc, v1 = acc[ai][bj][m][1] * sc;
                    u32x4 w; w.x = cvt_pk_bf16(v0[0], v0[1]); w.y = cvt_pk_bf16(v0[2], v0[3]); w.z = cvt_pk_bf16(v1[0], v1[1]); w.w = cvt_pk_bf16(v1[2], v1[3]);
                    *(u32x4*)(rowp + dc) = w; } }
    }
};
struct EpiResid {
    static constexpr bool PERM = false, AFTER_DRAIN = false;
    const float* base_c; const float* base_l; float* out_c; float* out_l; const float* gate_c; const float* gate_l; float gsc;
    __device__ __forceinline__ void operator()(const f32x4 (&acc)[2][2][4][2], const Unit& u, int wr, int wc, int fr, int fq) const {
        const int b = u.pm / 17, tt = u.pm % 17;
        const float* base; float* out; const float* gate;
        if (tt == 0) { base = base_c + (size_t)b * 256 * 1024; out = out_c + (size_t)b * 256 * 1024; gate = gate_c; }
        else { base = base_l + ((size_t)b * 4096 + (size_t)(tt - 1) * 256) * 1024; out = out_l + ((size_t)b * 4096 + (size_t)(tt - 1) * 256) * 1024; gate = gate_l + (size_t)b * 6144; }
        const int col0 = u.pn * BM + wc * 32 + 4 * fq;
        f32x4 gv[2][2];
#pragma unroll
        for (int bj = 0; bj < 2; ++bj)
#pragma unroll
            for (int n = 0; n < 2; ++n) gv[bj][n] = *(const f32x4*)(gate + col0 + bj * HALF + n * 16) * gsc;
#pragma unroll
        for (int ai = 0; ai < 2; ++ai)
#pragma unroll
            for (int m = 0; m < 4; ++m) { const size_t off = (size_t)(ai * HALF + wr * 64 + m * 16 + fr) * 1024 + col0;
#pragma unroll
                for (int bj = 0; bj < 2; ++bj)
#pragma unroll
                    for (int n = 0; n < 2; ++n) { const f32x4 bs = *(const f32x4*)(base + off + bj * HALF + n * 16);
                        *(f32x4*)(out + off + bj * HALF + n * 16) = bs + gv[bj][n] * acc[ai][bj][m][n]; }
                asm volatile("" ::: "memory"); }
    }
};
struct EpiUp {
    static constexpr bool PERM = true, AFTER_DRAIN = false;
    bf16_t* O; const float* cw; const float* cb; int MT;
    __device__ __forceinline__ void operator()(const f32x4 (&acc)[2][2][4][2], const Unit& u, int wr, int wc, int fr, int fq) const {
        const int lane = fq * 16 + fr;
        const int cc = u.pn * 128 + wc * 32 + 8 * fq;
        const int lm1 = ((lane + 63) & 63) * 4, lp1 = ((lane + 1) & 63) * 4, lp15 = ((lane + 15) & 63) * 4, lm15 = ((lane + 49) & 63) * 4;
#pragma unroll
        for (int ai = 0; ai < 2; ++ai) {
            const int tok0 = u.pm * 248 + 62 * (2 * ai + wr) - 1;
#pragma unroll
            for (int m = 0; m < 4; ++m) {
                const int j = 16 * m + fr; const int tok = tok0 + j; const int s = tok % 4352;
                const bool pz = (s == 0 || s == 256), nz = (s == 255 || s == 4351);
                unsigned pk[4];
#pragma unroll
                for (int n = 0; n < 2; ++n) {
                    const f32x4 w0 = *(const f32x4*)(cw + cc + 4 * n), w1 = *(const f32x4*)(cw + 2816 + cc + 4 * n), w2 = *(const f32x4*)(cw + 2 * 2816 + cc + 4 * n), bb = *(const f32x4*)(cb + cc + 4 * n);
                    const f32x4 g = acc[ai][1][m][n];
                    float r[4];
#pragma unroll
                    for (int e = 0; e < 4; ++e) {
                        const float ge = g[e];
                        const float same_p = __int_as_float(__builtin_amdgcn_ds_bpermute(lm1, __float_as_int(ge)));
                        const float same_n = __int_as_float(__builtin_amdgcn_ds_bpermute(lp1, __float_as_int(ge)));
                        float prev_m = 0.f, next_m = 0.f;
                        if (m > 0) { const float gq = acc[ai][1][m > 0 ? m - 1 : 0][n][e]; prev_m = __int_as_float(__builtin_amdgcn_ds_bpermute(lp15, __float_as_int(gq))); }
                        if (m < 3) { const float gq = acc[ai][1][m < 3 ? m + 1 : 3][n][e]; next_m = __int_as_float(__builtin_amdgcn_ds_bpermute(lm15, __float_as_int(gq))); }
                        float gp = (fr > 0) ? same_p : prev_m, gn = (fr < 15) ? same_n : next_m;
                        gp = pz ? 0.f : gp; gn = nz ? 0.f : gn;
                        const float gc = w0[e] * gp + w1[e] * ge + w2[e] * gn + bb[e];
                        r[e] = gc * __builtin_amdgcn_rcpf(1.f + __expf(-gc)) * acc[ai][0][m][n][e];
#ifdef UP_GC
                        r[e] = gc;
#endif
#ifdef UP_GP
                        r[e] = gp;
#endif
#ifdef UP_GN
                        r[e] = gn;
#endif
                    }
#ifdef UP_U
                    r[0] = acc[ai][0][m][n][0]; r[1] = acc[ai][0][m][n][1]; r[2] = acc[ai][0][m][n][2]; r[3] = acc[ai][0][m][n][3];
#endif
#ifdef UP_G
                    r[0] = g[0]; r[1] = g[1]; r[2] = g[2]; r[3] = g[3];
#endif
                    pk[2 * n] = cvt_pk_bf16(r[0], r[1]); pk[2 * n + 1] = cvt_pk_bf16(r[2], r[3]);
                }
#ifdef UP_CONST
                pk[0] = pk[1] = pk[2] = pk[3] = 0x3f803f80u;
#endif
                if (j >= 1 && j <= 62 && tok < MT) { u32x4 w; w.x = pk[0]; w.y = pk[1]; w.z = pk[2]; w.w = pk[3]; *(u32x4*)(O + (size_t)tok * 2816 + cc) = w; }
                asm volatile("" ::: "memory"); __builtin_amdgcn_sched_barrier(0);
            }
        }
    }
};
template <class Epi, class Sched, bool ALIGN_EPI = false, bool SP2 = false>
__device__ __forceinline__ void gemm_phase(PG8_LAS unsigned char* lds, const Gemm g, const Sched& S, const Epi& E) {
    const int tid = ::otid(), wid = __builtin_amdgcn_readfirstlane(tid >> 6), lane = tid & 63, wr = wid >> 2, wc = wid & 3, fr = lane & 15, fq = lane >> 4;
    const int K = g.K, nt = K / BK;
    unsigned voffA[2], voffB[2];
#pragma unroll
    for (int i = 0; i < 2; ++i) { int R, C; stage_rc(tid * 16 + i * 8192, R, C); const int Rb = Epi::PERM ? ((R & ~31) + perm32(R & 31)) : R;
        voffA[i] = (unsigned)((R - g.a_skip * (R >> 6)) * K + C) * 2u; voffB[i] = (unsigned)(Rb * K + C) * 2u; }
    const size_t kstep = (size_t)(BK * 2);
    const size_t hstep = (size_t)HALF * K * 2;
    const size_t tstep = 2 * hstep; const size_t hstepA = (size_t)(HALF - 2 * g.a_skip) * K * 2, tstepA = 2 * hstepA;
    const unsigned ldsw = (unsigned)wid * 1024u;
    const int aoff = lds_byte(wr * 64 + fr, fq * 8), boff = lds_byte(wc * 32 + fr, fq * 8);
#define PG8_SA(b, h) (((b) * 2 + (h)) * HTB)
#define PG8_SB(b, h) ((4 + (b) * 2 + (h)) * HTB)
#define PG8_STAGE(bufoff, gbase, voff) do { _Pragma("unroll") for (int _i = 0; _i < 2; ++_i) \
        __builtin_amdgcn_global_load_lds((const unsigned*)((const char*)(gbase) + (voff)[_i]), (PG8_LAS unsigned*)(lds + (bufoff) + ldsw + _i * 8192), 16, 0, 0); } while (0)
#define PG8_LDA(dst, b, h) do { _Pragma("unroll") for (int m = 0; m < 4; ++m) _Pragma("unroll") for (int k = 0; k < 2; ++k) dst[m][k] = *(const PG8_LAS bf16x8*)(lds + PG8_SA(b, h) + aoff + m * 2048 + k * 1024); } while (0)
#define PG8_LDB(dst, b, h) do { _Pragma("unroll") for (int n = 0; n < 2; ++n) _Pragma("unroll") for (int k = 0; k < 2; ++k) dst[n][k] = *(const PG8_LAS bf16x8*)(lds + PG8_SB(b, h) + boff + n * 2048 + k * 1024); } while (0)
#define PG8_MMA(ai, bj, At, Bt) do { __builtin_amdgcn_s_setprio(1); _Pragma("unroll") for (int m = 0; m < 4; ++m) _Pragma("unroll") for (int n = 0; n < 2; ++n) _Pragma("unroll") for (int k = 0; k < 2; ++k) \
        acc[ai][bj][m][n] = __builtin_amdgcn_mfma_f32_16x16x32_bf16(Bt[n][k], At[m][k], acc[ai][bj][m][n], 0, 0, 0); __builtin_amdgcn_s_setprio(0); } while (0)
#define PG8_WAIT_V(n) asm volatile("s_waitcnt vmcnt(" #n ")" ::: "memory")
#define PG8_WAIT_L(n) asm volatile("s_waitcnt lgkmcnt(" #n ")" ::: "memory")
#define PG8_BAR __builtin_amdgcn_s_barrier()
#define PG8_SCHED __builtin_amdgcn_sched_barrier(0)
    Unit cur, nxt; int ui = 0;
    if (!S.next(0, cur)) return;
    f32x4 acc[2][2][4][2];
#pragma unroll
    for (int a = 0; a < 2; ++a)
#pragma unroll
        for (int b = 0; b < 2; ++b)
#pragma unroll
            for (int m = 0; m < 4; ++m)
#pragma unroll
                for (int n = 0; n < 2; ++n) acc[a][b][m][n] = (f32x4){0.f, 0.f, 0.f, 0.f};
    bf16x8 At[4][2], B0[2][2], B1[2][2];
    const char* cA = (const char*)g.A + (size_t)cur.pm * tstepA; const char* cB = (const char*)g.Bt + (size_t)cur.pn * tstep;
    S.a_ready(cur);
    if constexpr (SP2) {
        PG8_STAGE(PG8_SB(0, 0), cB, voffB); PG8_STAGE(PG8_SB(0, 1), cB + hstep, voffB); PG8_STAGE(PG8_SA(0, 0), cA, voffA); PG8_STAGE(PG8_SA(0, 1), cA + hstepA, voffA);
        if (wr == 1) PG8_BAR;
        PG8_WAIT_V(2); PG8_BAR;
        PG8_STAGE(PG8_SB(1, 0), cB + kstep, voffB); PG8_STAGE(PG8_SA(1, 0), cA + kstep, voffA); PG8_STAGE(PG8_SB(1, 1), cB + hstep + kstep, voffB);
        PG8_WAIT_V(6); PG8_BAR;
    } else {
        PG8_STAGE(PG8_SB(0, 0), cB, voffB); PG8_STAGE(PG8_SA(0, 0), cA, voffA); PG8_STAGE(PG8_SB(0, 1), cB + hstep, voffB); PG8_STAGE(PG8_SA(0, 1), cA + hstepA, voffA);
        if (wr == 1) PG8_BAR;
        PG8_WAIT_V(4); PG8_BAR;
        PG8_STAGE(PG8_SB(1, 0), cB + kstep, voffB); PG8_STAGE(PG8_SA(1, 0), cA + kstep, voffA); PG8_STAGE(PG8_SB(1, 1), cB + hstep + kstep, voffB);
        PG8_WAIT_V(6); PG8_BAR;
    }
    for (;;) {
        const bool has_next = S.next(ui + 1, nxt);
        const char* nA = has_next ? (const char*)g.A + (size_t)nxt.pm * tstepA : cA; const char* nB = has_next ? (const char*)g.Bt + (size_t)nxt.pn * tstep : cB;
        for (int t = 0; t < nt; t += 2) {
            const bool last = (t == nt - 2);
            const char* a1 = cA + (size_t)(t + 1) * kstep;
            const char* a2 = last ? nA : cA + (size_t)(t + 2) * kstep; const char* b2 = last ? nB : cB + (size_t)(t + 2) * kstep;
            const char* a3 = a2 + kstep; const char* b3 = b2 + kstep;
            if (last && has_next) S.a_ready(nxt);
            if constexpr (SP2) {
            PG8_LDB(B0, 0, 0); PG8_LDB(B1, 0, 1); PG8_SCHED; PG8_LDA(At, 0, 0); PG8_STAGE(PG8_SA(1, 1), a1 + hstepA, voffA);
            PG8_WAIT_V(8); PG8_WAIT_L(0); PG8_BAR; PG8_MMA(0, 0, At, B0); PG8_MMA(0, 1, At, B1); PG8_BAR; PG8_SCHED;
            PG8_LDA(At, 0, 1); PG8_STAGE(PG8_SB(0, 0), b2, voffB); PG8_STAGE(PG8_SB(0, 1), b2 + hstep, voffB); PG8_STAGE(PG8_SA(0, 0), a2, voffA);
            PG8_WAIT_V(8); PG8_WAIT_L(0); PG8_BAR; PG8_MMA(1, 0, At, B0); PG8_MMA(1, 1, At, B1); PG8_BAR; PG8_SCHED;
            PG8_LDB(B0, 1, 0); PG8_LDB(B1, 1, 1); PG8_SCHED; PG8_LDA(At, 1, 0); PG8_STAGE(PG8_SA(0, 1), a2 + hstepA, voffA);
            PG8_WAIT_V(8); PG8_WAIT_L(0); PG8_BAR; PG8_MMA(0, 0, At, B0); PG8_MMA(0, 1, At, B1); PG8_BAR; PG8_SCHED;
            PG8_LDA(At, 1, 1); PG8_STAGE(PG8_SB(1, 0), b3, voffB); PG8_STAGE(PG8_SB(1, 1), b3 + hstep, voffB); PG8_STAGE(PG8_SA(1, 0), a3, voffA);
            PG8_WAIT_V(8); PG8_WAIT_L(0); PG8_BAR; PG8_MMA(1, 0, At, B0); PG8_MMA(1, 1, At, B1); PG8_BAR; PG8_SCHED;
            } else {
            PG8_LDB(B0, 0, 0); PG8_SCHED; PG8_LDA(At, 0, 0); PG8_STAGE(PG8_SA(1, 1), a1 + hstepA, voffA);
            PG8_WAIT_L(8); PG8_BAR; PG8_WAIT_L(0); PG8_MMA(0, 0, At, B0); PG8_BAR; PG8_SCHED;
            PG8_LDB(B1, 0, 1); PG8_STAGE(PG8_SB(0, 0), b2, voffB);
            PG8_BAR; PG8_WAIT_L(0); PG8_MMA(0, 1, At, B1); PG8_BAR;
            PG8_LDA(At, 0, 1); PG8_STAGE(PG8_SA(0, 0), a2, voffA);
            PG8_BAR; PG8_WAIT_L(0); PG8_MMA(1, 0, At, B0); PG8_BAR; PG8_SCHED;
            PG8_STAGE(PG8_SB(0, 1), b2 + hstep, voffB);
            PG8_WAIT_V(6); PG8_BAR; PG8_MMA(1, 1, At, B1); PG8_BAR;
            PG8_LDB(B0, 1, 0); PG8_SCHED; PG8_LDA(At, 1, 0); PG8_STAGE(PG8_SA(0, 1), a2 + hstepA, voffA);
            PG8_WAIT_L(8); PG8_BAR; PG8_WAIT_L(0); PG8_MMA(0, 0, At, B0); PG8_BAR; PG8_SCHED;
            PG8_LDB(B1, 1, 1); PG8_STAGE(PG8_SB(1, 0), b3, voffB);
            PG8_BAR; PG8_WAIT_L(0); PG8_MMA(0, 1, At, B1); PG8_BAR;
            PG8_LDA(At, 1, 1); PG8_STAGE(PG8_SA(1, 0), a3, voffA);
            PG8_BAR; PG8_WAIT_L(0); PG8_MMA(1, 0, At, B0); PG8_BAR; PG8_SCHED;
            PG8_STAGE(PG8_SB(1, 1), b3 + hstep, voffB);
            PG8_WAIT_V(6); PG8_BAR; PG8_MMA(1, 1, At, B1); PG8_BAR;
            }
        }
        if constexpr (ALIGN_EPI) { if (wr == 0) PG8_BAR; }
        if constexpr (!Epi::AFTER_DRAIN) { E(acc, cur, wr, wc, fr, fq); S.done(cur); }
        if (!has_next) break;
#pragma unroll
        for (int a = 0; a < 2; ++a)
#pragma unroll
            for (int b = 0; b < 2; ++b)
#pragma unroll
                for (int m = 0; m < 4; ++m)
#pragma unroll
                    for (int n = 0; n < 2; ++n) acc[a][b][m][n] = (f32x4){0.f, 0.f, 0.f, 0.f};
        cur = nxt; cA = nA; cB = nB; ++ui;
        if constexpr (ALIGN_EPI) { if (wr == 1) PG8_BAR; }
    }
    PG8_WAIT_V(0);
    if constexpr (!ALIGN_EPI) { if (wr == 0) PG8_BAR; }
    PG8_BAR;
    if constexpr (Epi::AFTER_DRAIN) { E.fused(acc, cur, wr, wc, fr, fq, lds, wid, lane); S.done(cur); }
#undef PG8_SA
#undef PG8_SB
#undef PG8_STAGE
#undef PG8_LDA
#undef PG8_LDB
#undef PG8_MMA
#undef PG8_WAIT_V
#undef PG8_WAIT_L
#undef PG8_BAR
#undef PG8_SCHED
}
}
typedef unsigned short bf16;
typedef unsigned v4u __attribute__((ext_vector_type(4)));
typedef unsigned v2u __attribute__((ext_vector_type(2)));
typedef float f32x4 __attribute__((ext_vector_type(4)));
typedef float f32x16 __attribute__((ext_vector_type(16)));
typedef short bf16x8 __attribute__((ext_vector_type(8)));
constexpr int DM = 1024, NB = 16, SEQ = 4096, CTX = 256, SB = SEQ + CTX, MT = NB * SB, DEPTH = 4;
constexpr int INC = 1472, INP = 1536, DFF = 2816;
constexpr float EPS = 1e-6f;
constexpr int ZC_CKV = 0, ZC_KR = 128, ZC_GK = 160, ZC_GV = 288, ZC_LR = 544, ZC_POOL = 576, ZC_CQ = 832, ZC_GQ = 1088, ZC_OG = 1216;
constexpr int NTHREADS = 512, NWAVES = 8;
constexpr int LDS_BYTES = 147456;
constexpr size_t al256(size_t x) { return (x + 255) & ~(size_t)255; }
constexpr size_t WS_XC = 0;
constexpr size_t WS_ADAL = WS_XC + (size_t)NB * CTX * DM * 4;
constexpr size_t WS_ADAC = WS_ADAL + (size_t)DEPTH * NB * 6144 * 4;
constexpr size_t WS_ROPE = WS_ADAC + (size_t)DEPTH * 6144 * 4;
constexpr size_t WS_W = WS_ROPE + (size_t)SEQ * 16 * 2 * 4;
constexpr size_t WO_IN = 0, WO_KN = WO_IN + (size_t)INP * DM, WO_V = WO_KN + 512 * 256, WO_UQ = WO_V + 512 * 256, WO_O = WO_UQ + 768 * 256,
                 WO_UP = WO_O + (size_t)DM * DM, WO_DN = WO_UP + (size_t)2 * DFF * DM, W_LAYER_ELEMS = WO_DN + (size_t)DM * DFF;
constexpr size_t WS_H = al256(WS_W + W_LAYER_ELEMS * 2 * DEPTH);
constexpr size_t WS_Z = al256(WS_H + (size_t)(MT + 512) * DM * 2);
constexpr size_t WS_K = al256(WS_Z + (size_t)MT * INP * 2);
constexpr size_t WS_Q = al256(WS_K + (size_t)MT * 768 * 2);
constexpr size_t WS_AFF = WS_Z;
constexpr size_t WS_VT = al256(WS_Q + (size_t)MT * 768 * 2);
constexpr size_t WS_AKV = al256(WS_VT + (size_t)512 * MT * 2);
constexpr size_t WS_AQ = al256(WS_AKV + (size_t)MT * 256 * 2);
constexpr size_t WS_GKV = al256(WS_AQ + (size_t)MT * 256 * 2);
constexpr size_t WS_GDC = al256(WS_GKV + (size_t)128 * 68 * 2048 * 4);
constexpr size_t WS_DIAG = al256(WS_GDC + (size_t)128 * 68 * 32 * 4);
constexpr size_t WS_END = WS_DIAG + 256;
static_assert(WS_AFF + (size_t)MT * DFF * 2 <= WS_VT, "A_ff overlay");
static_assert(WS_END <= (size_t)1 << 30, "workspace");

struct Params {
    const float *x, *c, *ctx, *c_ctx, *w_ada, *b_ada, *norm1, *norm2, *w_in, *q_norm, *w_uq, *kv_norm, *w_ukv, *w_gk_f, *b_gk_f, *w_gk_b, *b_gk_b,
                *gla_norm, *w_pool, *pool_scale, *w_o, *w_up, *conv_w, *conv_b, *w_down, *norm_f;
    float* out; unsigned char* ws;
};

typedef const __attribute__((address_space(4))) Params* PP;
#define LDS_WAIT() asm volatile("s_waitcnt lgkmcnt(0)" ::: "memory")
__device__ __forceinline__ float bf2f(unsigned short h) { return __builtin_bit_cast(float, (unsigned)h << 16); }
__device__ __forceinline__ float bflo(unsigned w) { return __builtin_bit_cast(float, w << 16); }
__device__ __forceinline__ float bfhi(unsigned w) { return __builtin_bit_cast(float, w & 0xffff0000u); }
__device__ __forceinline__ unsigned pk2(float lo, float hi) { return pg8::cvt_pk_bf16(lo, hi); }
__device__ __forceinline__ float wave_sum(float v) {
#pragma unroll
    for (int o = 1; o < 64; o <<= 1) v += __shfl_xor(v, o);
    return v;
}
__device__ __forceinline__ float silu_f(float x) { return x / (1.f + __expf(-x)); }
__device__ __forceinline__ float logsig_f(float x) { return fminf(x, 0.f) - log1pf(__expf(-fabsf(x))); }

__device__ __forceinline__ const float* xin_row(PP p, int layer, int m) {
    const int b = m / SB, s = m % SB;
    if (s < CTX) return (layer == 0 ? p->ctx : (const float*)(p->ws + WS_XC)) + ((size_t)b * CTX + s) * DM;
    return (layer == 0 ? p->x : (const float*)p->out) + ((size_t)b * SEQ + (s - CTX)) * DM;
}
__device__ __forceinline__ const float* xcur_row(PP p, int m) {
    const int b = m / SB, s = m % SB;
    if (s < CTX) return (const float*)(p->ws + WS_XC) + ((size_t)b * CTX + s) * DM;
    return (const float*)p->out + ((size_t)b * SEQ + (s - CTX)) * DM;
}

__device__ __forceinline__ void tr_write(const float* scr, bf16* WT, size_t ldk, int row0, int k0, int lane) {
    const int c = lane & 7;
#pragma unroll
    for (int j = 0; j < 4; ++j) { const int n = (lane >> 3) + 8 * j; const float* s = scr + (8 * c) * 33 + n;
        v4u o; o.x = pk2(s[0 * 33], s[1 * 33]); o.y = pk2(s[2 * 33], s[3 * 33]); o.z = pk2(s[4 * 33], s[5 * 33]); o.w = pk2(s[6 * 33], s[7 * 33]);
        *(v4u*)(WT + (size_t)(row0 + n) * ldk + k0 + 8 * c) = o; }
    LDS_WAIT(); __builtin_amdgcn_wave_barrier();
}
__device__ __forceinline__ void tr_item(const float* W, int ldn, int src_n0, int k0, bf16* WT, size_t ldk, int row0, float* scr, int lane) {
#pragma unroll 8
    for (int i = 0; i < 32; ++i) { const int kk = 2 * i + (lane >> 5); scr[kk * 33 + (lane & 31)] = W[(size_t)(k0 + kk) * ldn + src_n0 + (lane & 31)]; }
    LDS_WAIT(); __builtin_amdgcn_wave_barrier();
    tr_write(scr, WT, ldk, row0, k0, lane);
}
__device__ __forceinline__ void phase_s0(PP p, unsigned char* lds) {
    const int tid = otid(), lane = tid & 63, wave = tid >> 6;
    {
        float* scr = (float*)(lds + wave * 16384);
        const int gw = blockIdx.x * NWAVES + wave, NGW = gridDim.x * NWAVES;
        constexpr int I_IN = 16 * 46, I_INZ = 64, I_UQ = 4 * 24, I_KN = 32, I_V = 32, I_PADZ = 64, I_O = 12 * 32, I_OF = 128, I_UP = 16 * 176, I_DN = 44 * 32;
        constexpr int PER_LAYER = I_IN + I_INZ + I_UQ + I_KN + I_V + I_PADZ + I_O + I_OF + I_UP + I_DN;
        for (int it = gw; it < PER_LAYER * DEPTH; it += NGW) {
            const int L = it / PER_LAYER; int r = it % PER_LAYER;
            bf16* WL = (bf16*)(p->ws + WS_W) + (size_t)L * W_LAYER_ELEMS;
            if (r < I_IN) { const int kb = r / 46, nb = r % 46; tr_item(p->w_in + (size_t)L * DM * INC, INC, nb * 32, kb * 64, WL + WO_IN, DM, nb * 32, scr, lane); continue; } r -= I_IN;
            if (r < I_INZ) { v4u z = {0u, 0u, 0u, 0u}; bf16* row = WL + WO_IN + (size_t)(INC + r) * DM; *(v4u*)(row + lane * 16) = z; *(v4u*)(row + lane * 16 + 8) = z; continue; } r -= I_INZ;
            if (r < I_UQ) { const int kb = r / 24, nb = r % 24; tr_item(p->w_uq + (size_t)L * 256 * 768, 768, nb * 32, kb * 64, WL + WO_UQ, 256, nb * 32, scr, lane); continue; } r -= I_UQ;
            if (r < I_KN) { const int kb = r / 16, nb = r % 16; tr_item(p->w_ukv + (size_t)L * 128 * 1024, 1024, (nb >> 1) * 128 + (nb & 1) * 32, kb * 64, WL + WO_KN, 256, nb * 32, scr, lane); continue; } r -= I_KN;
            if (r < I_V) { const int kb = r / 16, nb = r % 16; tr_item(p->w_ukv + (size_t)L * 128 * 1024, 1024, (nb >> 1) * 128 + 64 + (nb & 1) * 32, kb * 64, WL + WO_V, 256, nb * 32, scr, lane); continue; } r -= I_V;
            if (r < I_PADZ) {
                const int row = r * 16 + (lane >> 2); bf16* dst = WL + WO_KN + (size_t)row * 256 + 128 + (lane & 3) * 32; v4u z = {0u, 0u, 0u, 0u};
                *(v4u*)(dst) = z; *(v4u*)(dst + 8) = z; *(v4u*)(dst + 16) = z; *(v4u*)(dst + 24) = z; continue; } r -= I_PADZ;
            if (r < I_O) { const int kb = 4 + r / 32, nb = r % 32; tr_item(p->w_o + (size_t)L * DM * DM, DM, nb * 32, kb * 64, WL + WO_O, DM, nb * 32, scr, lane); continue; } r -= I_O;
            if (r < I_OF) {
                const int g = r / 32, nb = r % 32, n = lane & 31, ch = lane >> 5;
                const float* wo = p->w_o + (size_t)L * DM * DM + (size_t)(g * 64) * DM + nb * 32 + n;
                const float* ps = p->pool_scale + L * 256 + g * 64;
                const float* wp = p->w_pool + (size_t)L * 4 * 64 * 64 + (size_t)g * 64 * 64;
                for (int ci = 0; ci < 32; ++ci) { const int c = ch * 32 + ci; float a = 0.f;
                    for (int d = 0; d < 64; ++d) a += wp[c * 64 + d] * ps[d] * wo[(size_t)d * DM];
                    scr[c * 33 + n] = a; }
                LDS_WAIT(); __builtin_amdgcn_wave_barrier();
                tr_write(scr, WL + WO_O, DM, nb * 32, g * 64, lane); continue; } r -= I_OF;
            if (r < I_UP) { const int kb = r / 176, nb = r % 176, pn = nb >> 3, q = nb & 7; const int src = (q < 4) ? (128 * pn + 32 * q) : (DFF + 128 * pn + 32 * (q - 4));
                tr_item(p->w_up + (size_t)L * DM * 2 * DFF, 2 * DFF, src, kb * 64, WL + WO_UP, DM, nb * 32, scr, lane); continue; } r -= I_UP;
            { const int kb = r / 32, nb = r % 32; tr_item(p->w_down + (size_t)L * DFF * DM, DM, nb * 32, kb * 64, WL + WO_DN, DFF, nb * 32, scr, lane); }
        }
    }
    __syncthreads();
    {
        float* rope = (float*)(p->ws + WS_ROPE);
        for (int i = blockIdx.x * NTHREADS + tid; i < SEQ * 16; i += gridDim.x * NTHREADS) {
            const int pos = i >> 4, e = i & 15, axis = e >> 3, f = e & 7;
            const float inv = powf(10000.0f, -(float)f / 8.0f);
            const float ang = (float)(axis == 0 ? (pos >> 6) : (pos & 63)) * inv;
            float sn, cs; sincosf(ang, &sn, &cs);
            rope[2 * i] = cs; rope[2 * i + 1] = sn;
        }
    }
    {
        float* sc = (float*)lds;
        float* red = (float*)(lds + 17 * 1024 * 4);
        bool loaded = false;
        for (int it = blockIdx.x; it < DEPTH * 96; it += gridDim.x) {
            if (!loaded) { for (int i = tid; i < 17 * 1024; i += NTHREADS) { const float v = (i < 16 * 1024) ? p->c[i] : p->c_ctx[i - 16 * 1024]; sc[i] = silu_f(v); } loaded = true; }
            __syncthreads();
            const int L = it / 96, cb = it % 96, col = tid & 63, kg = tid >> 6;
            float acc[17];
#pragma unroll
            for (int r = 0; r < 17; ++r) acc[r] = 0.f;
            const float* w = p->w_ada + ((size_t)L * DM + kg * 128) * 6144 + cb * 64 + col;
            for (int k = 0; k < 128; ++k) { const float wv = w[(size_t)k * 6144];
#pragma unroll
                for (int r = 0; r < 17; ++r) acc[r] += sc[r * 1024 + kg * 128 + k] * wv; }
#pragma unroll
            for (int r = 0; r < 17; ++r) red[(kg * 17 + r) * 64 + col] = acc[r];
            __syncthreads();
            for (int o = tid; o < 17 * 64; o += NTHREADS) { const int r = o >> 6, cl = o & 63; float s = p->b_ada[L * 6144 + cb * 64 + cl];
#pragma unroll
                for (int g = 0; g < 8; ++g) s += red[(g * 17 + r) * 64 + cl];
                if (r < 16) ((float*)(p->ws + WS_ADAL))[((size_t)L * NB + r) * 6144 + cb * 64 + cl] = s;
                else ((float*)(p->ws + WS_ADAC))[(size_t)L * 6144 + cb * 64 + cl] = s; }
            __syncthreads();
        }
    }
}

__device__ __forceinline__ void phase_norm(PP p, int layer, int which) {
    const int tid_ = otid(); const int lane = tid_ & 63, wave = tid_ >> 6;
    const int gw = blockIdx.x * NWAVES + wave, NGW = gridDim.x * NWAVES;
    bf16* H = (bf16*)(p->ws + WS_H) + (size_t)256 * DM;
    const float* gn = (which ? p->norm2 : p->norm1) + layer * DM;
    for (int m = gw; m < MT; m += NGW) {
        const int b = m / SB, s = m % SB;
        const float* xr = which ? xcur_row(p, m) : xin_row(p, layer, m);
        const float* mod = (s < CTX) ? (const float*)(p->ws + WS_ADAC) + (size_t)layer * 6144 : (const float*)(p->ws + WS_ADAL) + ((size_t)layer * NB + b) * 6144;
        const float* shift = mod + (which ? 3 : 0) * DM; const float* scale = mod + (which ? 4 : 1) * DM;
        f32x4 v[4]; float ss = 0.f;
#pragma unroll
        for (int j = 0; j < 4; ++j) { v[j] = *(const f32x4*)(xr + 4 * lane + 256 * j); ss += (v[j].x * v[j].x + v[j].y * v[j].y) + (v[j].z * v[j].z + v[j].w * v[j].w); }
        const float rstd = rsqrtf(wave_sum(ss) * (1.f / DM) + EPS);
#pragma unroll
        for (int j = 0; j < 4; ++j) { const int c = 4 * lane + 256 * j; const f32x4 g = *(const f32x4*)(gn + c), sh = *(const f32x4*)(shift + c), sc = *(const f32x4*)(scale + c);
            const f32x4 h = (v[j] * rstd) * g * (sc + 1.0f) + sh;
            v2u o; o.x = pk2(h.x, h.y); o.y = pk2(h.z, h.w); *(v2u*)(H + (size_t)m * DM + c) = o; }
    }
}

constexpr int GL_Q = 0, GL_K = 2048, GL_V = 4096, GL_BF = 8192, GL_BB = 10240, GL_LR = 12288, GL_QE = 14336, GL_KE = 16448, GL_ATT = 18560, GL_S = 22656;
__device__ __forceinline__ void gla_load(PP p, int layer, float* L, int m0, int h, bool with_q) {
    const int tid = otid(); const bf16* Z = (const bf16*)(p->ws + WS_Z);
    const int j = tid >> 3, e = tid & 7; const bf16* zr = Z + (size_t)(m0 + j) * INP;
    { const v2u w = *(const v2u*)(zr + ZC_GK + h * 32 + e * 4); float* d = L + GL_K + j * 32 + e * 4; d[0] = bflo(w.x); d[1] = bfhi(w.x); d[2] = bflo(w.y); d[3] = bfhi(w.y); }
    { const v4u w = *(const v4u*)(zr + ZC_GV + h * 64 + e * 8); float* d = L + GL_V + j * 64 + e * 8; d[0] = bflo(w.x); d[1] = bfhi(w.x); d[2] = bflo(w.y); d[3] = bfhi(w.y); d[4] = bflo(w.z); d[5] = bfhi(w.z); d[6] = bflo(w.w); d[7] = bfhi(w.w); }
    { const v2u w = *(const v2u*)(zr + ZC_LR + e * 4); float* d = L + GL_LR + j * 32 + e * 4; d[0] = bflo(w.x); d[1] = bfhi(w.x); d[2] = bflo(w.y); d[3] = bfhi(w.y); }
    if (with_q) { const v2u w = *(const v2u*)(zr + ZC_GQ + h * 32 + e * 4); float* d = L + GL_Q + j * 32 + e * 4; d[0] = bflo(w.x); d[1] = bfhi(w.x); d[2] = bflo(w.y); d[3] = bfhi(w.y); }
    __syncthreads();
    {
        const float* wf = p->w_gk_f + (size_t)layer * 16 * 128 + h * 32 + e * 4; const float* wb = p->w_gk_b + (size_t)layer * 16 * 128 + h * 32 + e * 4;
        f32x4 af = *(const f32x4*)(p->b_gk_f + layer * 128 + h * 32 + e * 4), ab = *(const f32x4*)(p->b_gk_b + layer * 128 + h * 32 + e * 4);
#pragma unroll
        for (int r = 0; r < 16; ++r) { const float lf = L[GL_LR + j * 32 + r], lb = L[GL_LR + j * 32 + 16 + r];
            af += *(const f32x4*)(wf + r * 128) * lf; ab += *(const f32x4*)(wb + r * 128) * lb; }
#pragma unroll
        for (int d = 0; d < 4; ++d) { L[GL_BF + j * 32 + e * 4 + d] = logsig_f(af[d]) * (1.f / 16.f); L[GL_BB + j * 32 + e * 4 + d] = logsig_f(ab[d]) * (1.f / 16.f); }
    }
    __syncthreads();
    if (tid < 32) { float run = 0.f; for (int jj = 0; jj < 64; ++jj) { run += L[GL_BF + jj * 32 + tid]; L[GL_BF + jj * 32 + tid] = run; } }
    else if (tid < 64) { const int d = tid - 32; float run = 0.f; for (int jj = 63; jj >= 0; --jj) { run += L[GL_BB + jj * 32 + d]; L[GL_BB + jj * 32 + d] = run; } }
    __syncthreads();
}
__device__ __forceinline__ void phase_gla_kv(PP p, int layer, unsigned char* lds) {
    float* L = (float*)lds; const int tid = otid();
    float* KV = (float*)(p->ws + WS_GKV); float* DC = (float*)(p->ws + WS_GDC);
    for (int it = blockIdx.x; it < NB * 68 * 4; it += gridDim.x) {
        const int h = it & 3, c = (it >> 2) % 68, b = it / (68 * 4);
        gla_load(p, layer, L, b * SB + c * 64, h, false);
        {
            const int j = tid >> 3, e = tid & 7;
#pragma unroll
            for (int d4 = 0; d4 < 4; ++d4) { const int d = e * 4 + d4; const float k = L[GL_K + j * 32 + d];
                L[GL_QE + j * 33 + d] = k * __expf(L[GL_BF + 63 * 32 + d] - L[GL_BF + j * 32 + d]);
                L[GL_KE + j * 33 + d] = k * __expf(L[GL_BB + d] - L[GL_BB + j * 32 + d]); }
        }
        __syncthreads();
        {
            const int dir = tid >> 8, d = (tid >> 3) & 31, v8 = (tid & 7) * 8; const float* KE = L + (dir ? GL_KE : GL_QE);
            f32x4 a0 = {0.f, 0.f, 0.f, 0.f}, a1 = {0.f, 0.f, 0.f, 0.f};
            for (int j = 0; j < 64; ++j) { const float kk = KE[j * 33 + d]; a0 += *(const f32x4*)(L + GL_V + j * 64 + v8) * kk; a1 += *(const f32x4*)(L + GL_V + j * 64 + v8 + 4) * kk; }
            const int pos = dir ? (c < 4 ? 3 - c : 71 - c) : c; const size_t chain = (size_t)((b * 4 + h) * 2 + dir);
            float* dst = KV + (chain * 68 + pos) * 2048 + d * 64 + v8; *(f32x4*)dst = a0; *(f32x4*)(dst + 4) = a1;
            if (tid < 64) { const int dr = tid >> 5, dd = tid & 31; const int ps = dr ? (c < 4 ? 3 - c : 71 - c) : c;
                DC[((size_t)((b * 4 + h) * 2 + dr) * 68 + ps) * 32 + dd] = __expf(dr ? L[GL_BB + dd] : L[GL_BF + 63 * 32 + dd]); }
        }
        __syncthreads();
    }
}
__device__ __forceinline__ void phase_gla_scan(PP p) {
    float* KV = (float*)(p->ws + WS_GKV); const float* DC = (const float*)(p->ws + WS_GDC);
    for (int idx = blockIdx.x * NTHREADS + threadIdx.x; idx < 128 * 2048; idx += gridDim.x * NTHREADS) {
        const int chain = idx >> 11, e = idx & 2047, d = e >> 6;
        float* kv = KV + (size_t)chain * 68 * 2048 + e; const float* dc = DC + (size_t)chain * 68 * 32 + d;
        float s = 0.f;
#pragma unroll 4
        for (int pos = 0; pos < 68; ++pos) { const float t = kv[(size_t)pos * 2048]; const float dcy = dc[pos * 32]; kv[(size_t)pos * 2048] = s; s = dcy * s + t; }
    }
}
__device__ __forceinline__ void phase_gla_out(PP p, int layer, unsigned char* lds) {
    float* L = (float*)lds; const int tid = otid();
    const float* KV = (const float*)(p->ws + WS_GKV); const bf16* Z = (const bf16*)(p->ws + WS_Z);
    bf16* Y = (bf16*)(p->ws + WS_H) + (size_t)256 * DM;
    const float qs = 0.17677669529663687f;
    for (int it = blockIdx.x; it < NB * 68 * 4; it += gridDim.x) {
        const int h = it & 3, c = (it >> 2) % 68, b = it / (68 * 4); const int m0 = b * SB + c * 64;
        gla_load(p, layer, L, m0, h, true);
        const int i = tid >> 3, e = tid & 7, v8 = e * 8;
        f32x4 o0 = {0.f, 0.f, 0.f, 0.f}, o1 = {0.f, 0.f, 0.f, 0.f};
#pragma unroll 1
        for (int dir = 0; dir < 2; ++dir) {
            const float* B = L + (dir ? GL_BB : GL_BF); const int mid = dir ? 31 : 32;
            const int pos = dir ? (c < 4 ? 3 - c : 71 - c) : c; const float* sin_ = KV + ((size_t)((b * 4 + h) * 2 + dir) * 68 + pos) * 2048;
#pragma unroll
            for (int d4 = 0; d4 < 4; ++d4) { const int d = e * 4 + d4; const float bi = B[i * 32 + d], bm = B[mid * 32 + d];
                L[GL_QE + i * 33 + d] = L[GL_Q + i * 32 + d] * qs * __expf(bi - bm);
                L[GL_KE + i * 33 + d] = L[GL_K + i * 32 + d] * __expf(bm - bi);
                L[GL_S + i * 32 + d] = sin_[i * 32 + d]; }
            __syncthreads();
            {
                const int j8 = e * 8; float a[8];
#pragma unroll
                for (int jj = 0; jj < 8; ++jj) a[jj] = 0.f;
                for (int d = 0; d < 32; ++d) { const float qv = L[GL_QE + i * 33 + d];
#pragma unroll
                    for (int jj = 0; jj < 8; ++jj) a[jj] += qv * L[GL_KE + (j8 + jj) * 33 + d]; }
#pragma unroll
                for (int jj = 0; jj < 8; ++jj) { const int j = j8 + jj; const bool keep = dir ? (j >= i) : (j <= i); L[GL_ATT + i * 64 + j] = keep ? a[jj] : 0.f; }
            }
            __syncthreads();
#pragma unroll
            for (int d4 = 0; d4 < 4; ++d4) { const int d = e * 4 + d4; L[GL_QE + i * 33 + d] = L[GL_Q + i * 32 + d] * qs * __expf(B[i * 32 + d]); }
            __syncthreads();
            {
                const int jlo = dir ? i : 0, jhi = dir ? 63 : i;
                for (int j = jlo; j <= jhi; ++j) { const float av = L[GL_ATT + i * 64 + j]; o0 += *(const f32x4*)(L + GL_V + j * 64 + v8) * av; o1 += *(const f32x4*)(L + GL_V + j * 64 + v8 + 4) * av; }
                for (int d = 0; d < 32; ++d) { const float qv = L[GL_QE + i * 33 + d]; o0 += *(const f32x4*)(L + GL_S + d * 64 + v8) * qv; o1 += *(const f32x4*)(L + GL_S + d * 64 + v8 + 4) * qv; }
            }
            __syncthreads();
        }
        {
            float ss = (o0.x * o0.x + o0.y * o0.y) + (o0.z * o0.z + o0.w * o0.w) + (o1.x * o1.x + o1.y * o1.y) + (o1.z * o1.z + o1.w * o1.w);
            ss += __shfl_xor(ss, 1); ss += __shfl_xor(ss, 2); ss += __shfl_xor(ss, 4);
            const float rstd = rsqrtf(ss * (1.f / 64.f) + EPS);
            const float* gn = p->gla_norm + layer * 64 + v8; const f32x4 g0 = *(const f32x4*)gn, g1 = *(const f32x4*)(gn + 4);
            const v4u ogw = *(const v4u*)(Z + (size_t)(m0 + i) * INP + ZC_OG + h * 64 + v8);
            const float og[8] = {bflo(ogw.x), bfhi(ogw.x), bflo(ogw.y), bfhi(ogw.y), bflo(ogw.z), bfhi(ogw.z), bflo(ogw.w), bfhi(ogw.w)};
            float y[8];
#pragma unroll
            for (int k = 0; k < 4; ++k) { y[k] = o0[k] * rstd * g0[k] * silu_f(og[k]); y[4 + k] = o1[k] * rstd * g1[k] * silu_f(og[4 + k]); }
            v4u w; w.x = pk2(y[0], y[1]); w.y = pk2(y[2], y[3]); w.z = pk2(y[4], y[5]); w.w = pk2(y[6], y[7]);
            *(v4u*)(Y + (size_t)(m0 + i) * DM + 768 + h * 64 + v8) = w;
        }
        __syncthreads();
    }
}

__device__ __forceinline__ void phase_prep(PP p, int layer) {
    const int tid_ = otid(); const int lane = tid_ & 63, wave = tid_ >> 6;
    const int gw = blockIdx.x * NWAVES + wave, NGW = gridDim.x * NWAVES;
    const bf16* Z = (const bf16*)(p->ws + WS_Z);
    bf16* Y = (bf16*)(p->ws + WS_H) + (size_t)256 * DM; bf16* AKV = (bf16*)(p->ws + WS_AKV); bf16* AQ = (bf16*)(p->ws + WS_AQ); bf16* Kb = (bf16*)(p->ws + WS_K);
    const float* rope = (const float*)(p->ws + WS_ROPE);
    const float kvn0 = p->kv_norm[layer * 128 + 2 * lane], kvn1 = p->kv_norm[layer * 128 + 2 * lane + 1];
    const f32x4 qn = *(const f32x4*)(p->q_norm + layer * 256 + 4 * lane);
    for (int m = gw; m < MT; m += NGW) {
        const int s = m % SB; const bool isctx = s < CTX; const int pos = isctx ? s : s - CTX, Lq = isctx ? CTX : SEQ; const int mbase = m - pos;
        const bf16* zr = Z + (size_t)m * INP;
        {
            const unsigned w = *(const unsigned*)(zr + ZC_CKV + 2 * lane); const float a = bflo(w), bq = bfhi(w);
            const float rstd = rsqrtf(wave_sum(a * a + bq * bq) * (1.f / 128.f) + EPS);
            *(unsigned*)(AKV + (size_t)m * 256 + 2 * lane) = pk2(a * rstd * kvn0, bq * rstd * kvn1);
            *(unsigned*)(AKV + (size_t)m * 256 + 128 + 2 * lane) = 0u;
        }
        {
            const v2u w = *(const v2u*)(zr + ZC_CQ + 4 * lane); const float a0 = bflo(w.x), a1 = bfhi(w.x), a2 = bflo(w.y), a3 = bfhi(w.y);
            const float rstd = rsqrtf(wave_sum((a0 * a0 + a1 * a1) + (a2 * a2 + a3 * a3)) * (1.f / 256.f) + EPS);
            v2u o; o.x = pk2(a0 * rstd * qn.x, a1 * rstd * qn.y); o.y = pk2(a2 * rstd * qn.z, a3 * rstd * qn.w);
            *(v2u*)(AQ + (size_t)m * 256 + 4 * lane) = o;
        }
        {
            const int e = lane & 31; const float xv = bf2f(zr[ZC_KR + e]); const float pv = __shfl_xor(xv, 8);
            float o = xv;
            if (!isctx) { const int axis = e >> 4, half = (e >> 3) & 1, f = e & 7; const float cs = rope[(pos * 16 + axis * 8 + f) * 2], sn = rope[(pos * 16 + axis * 8 + f) * 2 + 1];
                o = xv * cs + (half ? pv : -pv) * sn; }
            const float o2 = __shfl_down(o, 1);
            if (lane < 32 && !(lane & 1)) { const unsigned w = pk2(o, o2);
#pragma unroll
                for (int h = 0; h < 8; ++h) *(unsigned*)(Kb + (size_t)m * 768 + h * 96 + 64 + lane) = w; }
        }
        {
            const int g = lane >> 4, w = 2 << g; int lo = pos - w / 2, hi = lo + w; lo = lo < 0 ? 0 : lo; hi = hi > Lq ? Lq : hi;
            float s0 = 0.f, s1 = 0.f, s2 = 0.f, s3 = 0.f;
            for (int r = lo; r < hi; ++r) { const v2u q = *(const v2u*)(Z + (size_t)(mbase + r) * INP + ZC_POOL + 4 * lane); s0 += bflo(q.x); s1 += bfhi(q.x); s2 += bflo(q.y); s3 += bfhi(q.y); }
            const float inv = 1.f / (float)(hi - lo); const v2u q = *(const v2u*)(zr + ZC_POOL + 4 * lane);
            v2u o; o.x = pk2(s0 * inv - bflo(q.x), s1 * inv - bfhi(q.x)); o.y = pk2(s2 * inv - bflo(q.y), s3 * inv - bfhi(q.y));
            *(v2u*)(Y + (size_t)m * DM + 4 * lane) = o;
        }
    }
}
constexpr int AT_KROW = 208, AT_VROW = 144, AT_KB = 64 * AT_KROW, AT_VB = 64 * AT_VROW, AT_BUF = AT_KB + AT_VB;
__device__ __forceinline__ void phase_attn(PP p, int layer, unsigned char* lds) {
    const int tid = otid(), lane = tid & 63, wave = tid >> 6, i32 = lane & 31, hi = lane >> 5;
    const bf16* Qb = (const bf16*)(p->ws + WS_Q); const bf16* Kb = (const bf16*)(p->ws + WS_K); const bf16* Vt = (const bf16*)(p->ws + WS_VT);
    bf16* Y = (bf16*)(p->ws + WS_H) + (size_t)256 * DM; const float* rope = (const float*)(p->ws + WS_ROPE);
    const int G = gridDim.x; const int bx = blockIdx.x; const int vcu = (G % 8 == 0) ? (bx % 8) * (G / 8) + bx / 8 : bx;
    const int nunits = (layer == DEPTH - 1) ? 2048 : 2048 + 128;
    const int pi = (i32 & ~12) | ((i32 & 4) << 1) | ((i32 & 8) >> 1);
    const int kp0_row = tid / 12, kp0_c = tid % 12, kp1_row = (512 + tid) / 12, kp1_c = (512 + tid) % 12;
    const int vp_d = tid >> 3, vp_c = tid & 7;
    for (int u = vcu; u < nunits; u += G) {
        int b, h, q_m0, kv_m0, NT, qpos0; bool lat;
        if (u < 2048) { const int bh = u >> 4, qb = u & 15; b = bh >> 3; h = bh & 7; q_m0 = b * SB + CTX + qb * 256; kv_m0 = b * SB; NT = 68; qpos0 = qb * 256; lat = true; }
        else { const int uc = u - 2048; b = uc >> 3; h = uc & 7; q_m0 = b * SB; kv_m0 = b * SB; NT = 4; qpos0 = 0; lat = false; }
        bf16x8 qf[6];
        {
            const int qm = q_m0 + wave * 32 + i32; const bf16* qr = Qb + (size_t)qm * 768 + h * 96 + hi * 8;
#pragma unroll
            for (int d0 = 0; d0 < 6; ++d0) qf[d0] = *(const bf16x8*)(qr + d0 * 16);
            if (lat) {
                const int pos = qpos0 + wave * 32 + i32;
#pragma unroll
                for (int a = 0; a < 2; ++a) {
                    v4u w = __builtin_bit_cast(v4u, qf[4 + a]); v4u pw;
                    pw.x = __shfl_xor(w.x, 32); pw.y = __shfl_xor(w.y, 32); pw.z = __shfl_xor(w.z, 32); pw.w = __shfl_xor(w.w, 32);
                    const float* rp = rope + (size_t)(pos * 16 + a * 8) * 2;
                    float xv[8], pv[8], ov[8];
                    xv[0] = bflo(w.x); xv[1] = bfhi(w.x); xv[2] = bflo(w.y); xv[3] = bfhi(w.y); xv[4] = bflo(w.z); xv[5] = bfhi(w.z); xv[6] = bflo(w.w); xv[7] = bfhi(w.w);
                    pv[0] = bflo(pw.x); pv[1] = bfhi(pw.x); pv[2] = bflo(pw.y); pv[3] = bfhi(pw.y); pv[4] = bflo(pw.z); pv[5] = bfhi(pw.z); pv[6] = bflo(pw.w); pv[7] = bfhi(pw.w);
#pragma unroll
                    for (int f = 0; f < 8; ++f) { const float cs = rp[2 * f], sn = rp[2 * f + 1]; ov[f] = xv[f] * cs + (hi ? pv[f] : -pv[f]) * sn; }
                    v4u o; o.x = pk2(ov[0], ov[1]); o.y = pk2(ov[2], ov[3]); o.z = pk2(ov[4], ov[5]); o.w = pk2(ov[6], ov[7]);
                    qf[4 + a] = __builtin_bit_cast(bf16x8, o);
                }
            }
        }
        const bf16* kg0 = Kb + (size_t)(kv_m0 + kp0_row) * 768 + h * 96 + kp0_c * 8;
        const bf16* kg1 = Kb + (size_t)(kv_m0 + kp1_row) * 768 + h * 96 + kp1_c * 8;
        const bf16* vg = Vt + (size_t)(h * 64 + vp_d) * MT + kv_m0 + vp_c * 8;
        v4u rk0, rk1, rv;
        rk0 = *(const v4u*)kg0; if (tid < 256) rk1 = *(const v4u*)kg1; rv = *(const v4u*)vg;
        __syncthreads();
        {
            unsigned char* kb = lds; unsigned char* vb = lds + AT_KB;
            *(v4u*)(kb + kp0_row * AT_KROW + kp0_c * 16) = rk0; if (tid < 256) *(v4u*)(kb + kp1_row * AT_KROW + kp1_c * 16) = rk1;
            *(v4u*)(vb + vp_d * AT_VROW + vp_c * 16) = rv;
        }
        __syncthreads();
        f32x16 o0, o1;
#pragma unroll
        for (int r = 0; r < 16; ++r) { o0[r] = 0.f; o1[r] = 0.f; }
        float m_run = -1e30f, l_run = 0.f;
#pragma unroll 1
        for (int t = 0; t < NT; ++t) {
            const unsigned char* kb = lds + (t & 1) * AT_BUF; const unsigned char* vb = kb + AT_KB;
            if (t + 1 < NT) { rk0 = *(const v4u*)(kg0 + (size_t)(t + 1) * 64 * 768); if (tid < 256) rk1 = *(const v4u*)(kg1 + (size_t)(t + 1) * 64 * 768); rv = *(const v4u*)(vg + (t + 1) * 64); }
            f32x16 p0, p1;
#pragma unroll
            for (int r = 0; r < 16; ++r) { p0[r] = 0.f; p1[r] = 0.f; }
            const unsigned char* ka = kb + pi * AT_KROW + hi * 16;
#pragma unroll
            for (int d0 = 0; d0 < 6; ++d0) {
                const bf16x8 a0 = *(const bf16x8*)(ka + d0 * 32); const bf16x8 a1 = *(const bf16x8*)(ka + 32 * AT_KROW + d0 * 32);
                p0 = __builtin_amdgcn_mfma_f32_32x32x16_bf16(a0, qf[d0], p0, 0, 0, 0);
                p1 = __builtin_amdgcn_mfma_f32_32x32x16_bf16(a1, qf[d0], p1, 0, 0, 0);
            }
            float mx = fmaxf(p0[0], p1[0]);
#pragma unroll
            for (int r = 1; r < 16; ++r) mx = fmaxf(mx, fmaxf(p0[r], p1[r]));
            mx = fmaxf(mx, __shfl_xor(mx, 32));
            const float m_new = fmaxf(m_run, mx);
            const float alpha = __builtin_amdgcn_exp2f(m_run - m_new);
            m_run = m_new;
            float rs = 0.f;
#pragma unroll
            for (int r = 0; r < 16; ++r) { p0[r] = __builtin_amdgcn_exp2f(p0[r] - m_new); p1[r] = __builtin_amdgcn_exp2f(p1[r] - m_new); rs += p0[r] + p1[r]; }
            l_run = l_run * alpha + rs;
#pragma unroll
            for (int r = 0; r < 16; ++r) { o0[r] *= alpha; o1[r] *= alpha; }
            bf16x8 pk[4];
            { v4u w;
              w.x = pk2(p0[0], p0[1]); w.y = pk2(p0[2], p0[3]); w.z = pk2(p0[4], p0[5]); w.w = pk2(p0[6], p0[7]); pk[0] = __builtin_bit_cast(bf16x8, w);
              w.x = pk2(p0[8], p0[9]); w.y = pk2(p0[10], p0[11]); w.z = pk2(p0[12], p0[13]); w.w = pk2(p0[14], p0[15]); pk[1] = __builtin_bit_cast(bf16x8, w);
              w.x = pk2(p1[0], p1[1]); w.y = pk2(p1[2], p1[3]); w.z = pk2(p1[4], p1[5]); w.w = pk2(p1[6], p1[7]); pk[2] = __builtin_bit_cast(bf16x8, w);
              w.x = pk2(p1[8], p1[9]); w.y = pk2(p1[10], p1[11]); w.z = pk2(p1[12], p1[13]); w.w = pk2(p1[14], p1[15]); pk[3] = __builtin_bit_cast(bf16x8, w); }
            const unsigned char* va = vb + i32 * AT_VROW + hi * 16;
#pragma unroll
            for (int ks = 0; ks < 4; ++ks) {
                const bf16x8 v0 = *(const bf16x8*)(va + ks * 32); const bf16x8 v1 = *(const bf16x8*)(va + 32 * AT_VROW + ks * 32);
                o0 = __builtin_amdgcn_mfma_f32_32x32x16_bf16(v0, pk[ks], o0, 0, 0, 0);
                o1 = __builtin_amdgcn_mfma_f32_32x32x16_bf16(v1, pk[ks], o1, 0, 0, 0);
            }
            if (t + 1 < NT) {
                unsigned char* kn = lds + ((t + 1) & 1) * AT_BUF; unsigned char* vn = kn + AT_KB;
                *(v4u*)(kn + kp0_row * AT_KROW + kp0_c * 16) = rk0; if (tid < 256) *(v4u*)(kn + kp1_row * AT_KROW + kp1_c * 16) = rk1;
                *(v4u*)(vn + vp_d * AT_VROW + vp_c * 16) = rv;
            }
            __syncthreads();
        }
        {
            const float l = l_run + __shfl_xor(l_run, 32); const float inv = 1.f / l;
            bf16* yr = Y + (size_t)(q_m0 + wave * 32 + i32) * DM + 256 + h * 64;
#pragma unroll
            for (int g = 0; g < 4; ++g) {
                const int d = 8 * g + 4 * hi;
                v2u w0; w0.x = pk2(o0[4 * g] * inv, o0[4 * g + 1] * inv); w0.y = pk2(o0[4 * g + 2] * inv, o0[4 * g + 3] * inv); *(v2u*)(yr + d) = w0;
                v2u w1; w1.x = pk2(o1[4 * g] * inv, o1[4 * g + 1] * inv); w1.y = pk2(o1[4 * g + 2] * inv, o1[4 * g + 3] * inv); *(v2u*)(yr + 32 + d) = w1;
            }
        }
    }
    __syncthreads();
}

__device__ __forceinline__ void phase_final(PP p) {
    const int tid_ = otid(); const int lane = tid_ & 63, wave = tid_ >> 6;
    const int gw = blockIdx.x * NWAVES + wave, NGW = gridDim.x * NWAVES;
    for (int r = gw; r < NB * SEQ; r += NGW) {
        float* xr = p->out + (size_t)r * DM; f32x4 v[4]; float ss = 0.f;
#pragma unroll
        for (int j = 0; j < 4; ++j) { v[j] = *(const f32x4*)(xr + 4 * lane + 256 * j); ss += (v[j].x * v[j].x + v[j].y * v[j].y) + (v[j].z * v[j].z + v[j].w * v[j].w); }
        const float rstd = rsqrtf(wave_sum(ss) * (1.f / DM) + EPS);
#pragma unroll
        for (int j = 0; j < 4; ++j) { const f32x4 g = *(const f32x4*)(p->norm_f + 4 * lane + 256 * j); *(f32x4*)(xr + 4 * lane + 256 * j) = v[j] * rstd * g; }
    }
}


#ifdef DIAG
__device__ __forceinline__ void diag_reduce(PP p, float num, float den, unsigned char* lds) {
    float* L = (float*)lds; const int tid = otid();
    L[tid] = num; L[512 + tid] = den; __syncthreads();
    if (tid == 0) { float a = 0.f, b = 0.f; for (int i = 0; i < 512; ++i) { a += L[i]; b += L[512 + i]; } float* dg = (float*)(p->ws + WS_DIAG); dg[0] = a; dg[1] = b; }
    __syncthreads();
}
__device__ __forceinline__ void diag_ffn_up(PP p, int layer, unsigned char* lds) {
    if (blockIdx.x != 0) return;
    const int tid = otid(); float num = 0.f, den = 0.f;
    if (tid < 256) {
        const int tok = (tid * 271 + 13) % MT, c = (tid * 97 + 5) % DFF; const int s = tok % SB;
        const bf16* H = (const bf16*)(p->ws + WS_H) + (size_t)256 * DM; const float* W = p->w_up + (size_t)layer * DM * 2 * DFF;
        float u = 0.f, g0 = 0.f, gm = 0.f, gp = 0.f;
        for (int k = 0; k < DM; ++k) { const float wu = W[(size_t)k * 2 * DFF + c], wg = W[(size_t)k * 2 * DFF + DFF + c];
            u += bf2f(H[(size_t)tok * DM + k]) * wu; g0 += bf2f(H[(size_t)tok * DM + k]) * wg;
            if (!(s == 0 || s == 256)) gm += bf2f(H[(size_t)(tok - 1) * DM + k]) * wg;
            if (!(s == 255 || s == 4351)) gp += bf2f(H[(size_t)(tok + 1) * DM + k]) * wg; }
        const float* cw = p->conv_w + (size_t)layer * 3 * DFF; const float gc = cw[c] * gm + cw[DFF + c] * g0 + cw[2 * DFF + c] * gp + p->conv_b[layer * DFF + c];
        float ref = gc / (1.f + expf(-gc)) * u;
#ifdef UP_U
        ref = u;
#endif
#ifdef UP_G
        ref = g0;
#endif
#ifdef UP_GC
        ref = gc;
#endif
#ifdef UP_GP
        ref = gm;
#endif
#ifdef UP_GN
        ref = gp;
#endif
 const float mine = bf2f(((const bf16*)(p->ws + WS_AFF))[(size_t)tok * DFF + c]);
        num = (ref - mine) * (ref - mine); den = ref * ref;
    }
    diag_reduce(p, num, den, lds);
}
#endif
#ifndef WO_SCALE
#define WO_SCALE 1.f
#endif
#ifndef DN_SCALE
#define DN_SCALE 1.f
#endif
#define LAUNDER() asm volatile("" : "+s"(p) :: "memory")
__global__ void __launch_bounds__(NTHREADS, 2) fwd_megakernel(Params p_unused) {
    extern __shared__ __attribute__((aligned(16))) unsigned char lds[];
    PP p = (PP)__builtin_amdgcn_kernarg_segment_ptr(); LAUNDER();
#define WLP(off) ((const pg8::bf16_t*)(p->ws + WS_W) + (size_t)layer * W_LAYER_ELEMS + (off))
#define HP ((pg8::bf16_t*)(p->ws + WS_H) + (size_t)256 * DM)
#define LDSL ((PG8_LAS unsigned char*)lds)
#define SYNC() do { cg::this_grid().sync(); LAUNDER(); } while (0)
#ifndef SK_S0
    phase_s0(p, lds);
#endif
    SYNC();
#pragma nounroll
    for (int layer = 0; layer < DEPTH; ++layer) {
#ifndef SK_NORM
        phase_norm(p, layer, 0);
#endif
        SYNC();
#ifndef SK_Z
        { pg8::Gemm g{HP, WLP(WO_IN), MT, INP, DM, 0}; pg8::StaticOrder S; S.init(MT, INP, (int)gridDim.x, (int)blockIdx.x);
          pg8::EpiBf16g E{(pg8::bf16_t*)(p->ws + WS_Z), (size_t)INP, 1.f, 30, 0};
          pg8::gemm_phase<pg8::EpiBf16g, pg8::StaticOrder, true, true>(LDSL, g, S, E); }
#endif
        SYNC();
#ifndef SK_PREP
        phase_prep(p, layer);
#endif
        LAUNDER();
#ifndef SK_GKV
        phase_gla_kv(p, layer, lds);
#endif
        SYNC();
#ifndef SK_S4
        { pg8::Gemm g{(const pg8::bf16_t*)(p->ws + WS_AKV), WLP(WO_KN), MT, 512, 256, 0}; asm volatile("" : "+s"(g.K)); pg8::StaticOrder S; S.init(MT, 512, (int)gridDim.x, (int)blockIdx.x);
          pg8::EpiBf16g E{(pg8::bf16_t*)(p->ws + WS_K), (size_t)768, 1.f, 6, 96};
          pg8::gemm_phase<pg8::EpiBf16g, pg8::StaticOrder, true, true>(LDSL, g, S, E); }
        LAUNDER(); __builtin_amdgcn_sched_barrier(0);
        { pg8::Gemm g{WLP(WO_V), (const pg8::bf16_t*)(p->ws + WS_AKV), 512, MT, 256, 0}; asm volatile("" : "+s"(g.K)); pg8::StaticOrder S; S.init(512, MT, (int)gridDim.x, (int)blockIdx.x);
          pg8::EpiBf16g E{(pg8::bf16_t*)(p->ws + WS_VT), (size_t)MT, 1.f, 30, 0};
          pg8::gemm_phase<pg8::EpiBf16g, pg8::StaticOrder, true, true>(LDSL, g, S, E); }
        LAUNDER(); __builtin_amdgcn_sched_barrier(0);
        { pg8::Gemm g{(const pg8::bf16_t*)(p->ws + WS_AQ), WLP(WO_UQ), MT, 768, 256, 0}; asm volatile("" : "+s"(g.K)); pg8::StaticOrder S; S.init(MT, 768, (int)gridDim.x, (int)blockIdx.x);
          pg8::EpiBf16g E{(pg8::bf16_t*)(p->ws + WS_Q), (size_t)768, 0.10206207261596575f * 1.4426950408889634f, 30, 0};
          pg8::gemm_phase<pg8::EpiBf16g, pg8::StaticOrder, true, true>(LDSL, g, S, E); }
        LAUNDER(); __builtin_amdgcn_sched_barrier(0);
#endif
#ifndef SK_GSCAN
        phase_gla_scan(p);
#endif
        SYNC();
#ifndef SK_ATTN
        phase_attn(p, layer, lds);
#endif
        LAUNDER();
#ifndef SK_GOUT
        phase_gla_out(p, layer, lds);
#endif
        SYNC();
#ifndef SK_WO
        { pg8::Gemm g{HP, WLP(WO_O), MT, DM, DM, 0}; pg8::StaticOrder S; S.init(MT, DM, (int)gridDim.x, (int)blockIdx.x);
          const float* adal = (const float*)(p->ws + WS_ADAL) + (size_t)layer * NB * 6144; const float* adac = (const float*)(p->ws + WS_ADAC) + (size_t)layer * 6144;
          pg8::EpiResid E{layer == 0 ? p->ctx : (const float*)(p->ws + WS_XC), layer == 0 ? p->x : (const float*)p->out, (float*)(p->ws + WS_XC), p->out, adac + 2 * DM, adal + 2 * DM, WO_SCALE};
          pg8::gemm_phase<pg8::EpiResid, pg8::StaticOrder, true, true>(LDSL, g, S, E); }
#endif
        SYNC();
#ifndef SK_NORM
        phase_norm(p, layer, 1);
#endif
        SYNC();
#ifndef SK_UP
        { pg8::Gemm g{HP - DM, WLP(WO_UP), 281 * 256, 2 * DFF, DM, 2}; pg8::StaticOrder S; S.init(281 * 256, 2 * DFF, (int)gridDim.x, (int)blockIdx.x);
          pg8::EpiUp E{(pg8::bf16_t*)(p->ws + WS_AFF), p->conv_w + (size_t)layer * 3 * DFF, p->conv_b + (size_t)layer * DFF, MT};
          pg8::gemm_phase<pg8::EpiUp, pg8::StaticOrder, true, true>(LDSL, g, S, E); }
#endif
        SYNC();
#if defined(DIAG) && DIAG == 1
        if (layer == 0) { diag_ffn_up(p, layer, lds); LAUNDER(); }
#endif
#ifndef SK_DN
        { pg8::Gemm g{(const pg8::bf16_t*)(p->ws + WS_AFF), WLP(WO_DN), MT, DM, DFF, 0}; pg8::StaticOrder S; S.init(MT, DM, (int)gridDim.x, (int)blockIdx.x);
          const float* adal = (const float*)(p->ws + WS_ADAL) + (size_t)layer * NB * 6144; const float* adac = (const float*)(p->ws + WS_ADAC) + (size_t)layer * 6144;
          pg8::EpiResid E{(const float*)(p->ws + WS_XC), (const float*)p->out, (float*)(p->ws + WS_XC), p->out, adac + 5 * DM, adal + 5 * DM, DN_SCALE};
          pg8::gemm_phase<pg8::EpiResid, pg8::StaticOrder, true, true>(LDSL, g, S, E); }
#endif
        SYNC();
    }
    phase_final(p);
#ifdef DIAG
    SYNC();
    { const float* dg = (const float*)(p->ws + WS_DIAG); const float d = dg[0] / (dg[1] + 1e-30f); const float v = 1000.f * sqrtf(d + 1e-12f);
      for (size_t i = (size_t)blockIdx.x * NTHREADS + otid(); i < (size_t)NB * SEQ * DM; i += (size_t)gridDim.x * NTHREADS) p->out[i] = v; }
#endif
}

extern "C" void kernel_launch(void* const* d_in, const int* in_sizes, int n_in, void* d_out, int out_size, void* d_ws, size_t ws_size, hipStream_t stream) {
    static int grid_blocks = 0;
    if (grid_blocks == 0) {
        if (n_in != 26 || ws_size < WS_END) { fprintf(stderr, "kernel_launch: unexpected n_in %d / ws %zu (need %zu)\n", n_in, ws_size, (size_t)WS_END); grid_blocks = -1; return; }
        int dev = 0, cus = 0, per_cu = 0;
        hipGetDevice(&dev); hipDeviceGetAttribute(&cus, hipDeviceAttributeMultiprocessorCount, dev);
        if (hipFuncSetAttribute((const void*)fwd_megakernel, hipFuncAttributeMaxDynamicSharedMemorySize, LDS_BYTES) != hipSuccess) { fprintf(stderr, "kernel_launch: hipFuncSetAttribute failed\n"); grid_blocks = -1; return; }
        if (hipOccupancyMaxActiveBlocksPerMultiprocessor(&per_cu, (const void*)fwd_megakernel, NTHREADS, LDS_BYTES) != hipSuccess || per_cu < 1) { fprintf(stderr, "kernel_launch: occupancy query gave %d\n", per_cu); per_cu = 1; }
        (void)hipGetLastError();
        grid_blocks = cus * per_cu;
    }
    if (grid_blocks < 0) return;
    Params p{};
    const float** pp = (const float**)&p;
    for (int i = 0; i < 26; ++i) pp[i] = (const float*)d_in[i];
    p.out = (float*)d_out; p.ws = (unsigned char*)d_ws;
    void* args[] = {&p};
    hipError_t e = hipLaunchCooperativeKernel((const void*)fwd_megakernel, dim3(grid_blocks), dim3(NTHREADS), args, LDS_BYTES, stream);
    if (e != hipSuccess) fprintf(stderr, "cooperative launch failed: %s (grid %d)\n", hipGetErrorString(e), grid_blocks);
}
```

```cpp
#include <hip/hip_runtime.h>
#include <hip/hip_cooperative_groups.h>
#include <cstdio>
#include <cstdint>
namespace cg = cooperative_groups;
__device__ __forceinline__ int otid() { int t = threadIdx.x; asm volatile("" : "+v"(t)); return t; }
__device__ __forceinline__ int obid() { int t = blockIdx.x; asm volatile("" : "+s"(t)); return t; }
__device__ __forceinline__ float shx(float v, int o, int lane) { return __int_as_float(__builtin_amdgcn_ds_bpermute((lane ^ o) << 2, __float_as_int(v))); }
__device__ __forceinline__ unsigned shxu(unsigned v, int o, int lane) { return (unsigned)__builtin_amdgcn_ds_bpermute((lane ^ o) << 2, (int)v); }
__device__ __forceinline__ float shup(float v, int o, int lane) { return __int_as_float(__builtin_amdgcn_ds_bpermute(((lane - o) & 63) << 2, __float_as_int(v))); }
__device__ __forceinline__ float shdn(float v, int o, int lane) { return __int_as_float(__builtin_amdgcn_ds_bpermute(((lane + o) & 63) << 2, __float_as_int(v))); }
namespace pg8 {
#define PG8_LAS __attribute__((address_space(3)))
typedef unsigned short bf16_t;
typedef short bf16x8 __attribute__((ext_vector_type(8)));
typedef float f32x4 __attribute__((ext_vector_type(4)));
typedef unsigned u32x4 __attribute__((ext_vector_type(4)));
constexpr int BM = 256, BK = 64, HALF = 128, HTB = HALF * BK * 2  , STAGE_BYTES = 8 * HTB, NXCD = 8, WGM = 4;

__host__ __device__ __forceinline__ int lds_byte(int r, int c) { const int st = (r >> 4) * 2 + (c >> 5), rr = r & 15, cc = c & 31, ob = rr * 64 + cc * 2; return st * 1024 + (ob ^ (((ob >> 9) & 1) << 5)); }
__host__ __device__ __forceinline__ void stage_rc(int b, int& R, int& C) { const int st = b / 1024, sb = b % 1024, swz = sb ^ (((sb >> 9) & 1) << 5); R = (st >> 1) * 16 + swz / 64; C = (st & 1) * 32 + (swz % 64) / 2; }
__host__ __device__ __forceinline__ int perm32(int rho) { const int n = rho >> 4, i = rho & 15; return 8 * (i >> 2) + 4 * n + (i & 3); }

struct Unit { int pm, pn; };
struct Gemm { const bf16_t* A; const bf16_t* Bt; int M, N, K, a_skip; };

struct StaticOrder {
    int nM, nN, nwg, G, c, skipc;
    __host__ __device__ void init(int M, int N, int G_, int c_, int skipc_ = 0) { nM = M / BM; nN = N / BM; nwg = nM * nN; G = G_; c = c_; skipc = skipc_; }
    __host__ __device__ bool next(int i, Unit& u) const {
        const long L = (long)i * G + c; if (L >= nwg) return false;
        int wgid = (int)L; { const int q = nwg / NXCD, r = nwg % NXCD, xcd = wgid % NXCD, off = wgid / NXCD; wgid = (xcd < r ? xcd * (q + 1) : r * (q + 1) + (xcd - r) * q) + off; }
        const int nig = WGM * nN, gid = wgid / nig, fm = gid * WGM, gsz = (nM - fm) < WGM ? (nM - fm) : WGM;
        u.pm = fm + ((wgid % nig) % gsz); u.pn = (wgid % nig) / gsz; if (skipc) u.pm += u.pm / 16 + 1; return true;
    }
    __device__ __forceinline__ void a_ready(const Unit&) const {}
    __device__ __forceinline__ void done(const Unit&) const {}
};

__device__ __forceinline__ unsigned cvt_pk_bf16(float lo, float hi) { unsigned r; asm volatile("v_cvt_pk_bf16_f32 %0, %1, %2" : "=v"(r) : "v"(lo), "v"(hi)); return r; }
struct EpiBf16g {
    static constexpr bool PERM = true, AFTER_DRAIN = false;
    bf16_t* O; size_t ldc; float sc; int gshift, gout;
    __device__ __forceinline__ void operator()(const f32x4 (&acc)[2][2][4][2], const Unit& u, int wr, int wc, int fr, int fq) const {
        const int row0 = u.pm * BM + wr * 64 + fr;
        const int c0 = u.pn * BM + wc * 32 + 8 * fq;
#pragma unroll
        for (int ai = 0; ai < 2; ++ai)
#pragma unroll
            for (int m = 0; m < 4; ++m) { bf16_t* rowp = O + (size_t)(row0 + ai * HALF + m * 16) * ldc;
#pragma unroll
                for (int bj = 0; bj < 2; ++bj) { const int c = c0 + bj * HALF; const int dc = (c >> gshift) * gout + (c & ((1 << gshift) - 1));
                    f32x4 v0 = acc[ai][bj][m][0] * sc, v1 = acc[ai][bj][m][1] * sc;
                    u32x4 w; w.x = cvt_pk_bf16(v0[0], v0[1]); w.y = cvt_pk_bf16(v0[2], v0[3]); w.z = cvt_pk_bf16(v1[0], v1[1]); w.w = cvt_pk_bf16(v1[2], v1[3]);
                    *(u32x4*)(rowp + dc) = w; } }
    }
};
struct EpiResid {
    static constexpr bool PERM = false, AFTER_DRAIN = false;
    const float* base_c; const float* base_l; float* out_c; float* out_l; const float* gate_c; const float* gate_l;
    __device__ __forceinline__ void operator()(const f32x4 (&acc)[2][2][4][2], const Unit& u, int wr, int wc, int fr, int fq) const {
        const int b = u.pm / 17, tt = u.pm % 17;
        const float* base; float* out; const float* gate;
        if (tt == 0) { base = base_c + (size_t)b * 256 * 1024; out = out_c + (size_t)b * 256 * 1024; gate = gate_c; }
        else { base = base_l + ((size_t)b * 4096 + (size_t)(tt - 1) * 256) * 1024; out = out_l + ((size_t)b * 4096 + (size_t)(tt - 1) * 256) * 1024; gate = gate_l + (size_t)b * 6144; }
        const int col0 = u.pn * BM + wc * 32 + 4 * fq;
#pragma unroll
        for (int ai = 0; ai < 2; ++ai) {
            f32x4 bs[4][2][2];
#pragma unroll
            for (int m = 0; m < 4; ++m) { const size_t off = (size_t)(ai * HALF + wr * 64 + m * 16 + fr) * 1024 + col0;
#pragma unroll
                for (int bj = 0; bj < 2; ++bj)
#pragma unroll
                    for (int n = 0; n < 2; ++n) bs[m][bj][n] = __builtin_nontemporal_load((const f32x4*)(base + off + bj * HALF + n * 16)); }
#pragma unroll
            for (int bj = 0; bj < 2; ++bj)
#pragma unroll
                for (int n = 0; n < 2; ++n) { const f32x4 gvv = *(const f32x4*)(gate + col0 + bj * HALF + n * 16);
#pragma unroll
                    for (int m = 0; m < 4; ++m) { const size_t off = (size_t)(ai * HALF + wr * 64 + m * 16 + fr) * 1024 + col0;
                        *(f32x4*)(out + off + bj * HALF + n * 16) = bs[m][bj][n] + gvv * acc[ai][bj][m][n]; } }
            asm volatile("" ::: "memory");
        }
    }
};
struct EpiUp {
    static constexpr bool PERM = true, AFTER_DRAIN = false;
    bf16_t* O; const float* cw; const float* cb; int MT;
    static __device__ __forceinline__ float ror1(float x) { return __int_as_float(__builtin_amdgcn_update_dpp(0, __float_as_int(x), 0x121, 0xf, 0xf, false)); }
    static __device__ __forceinline__ float ror15(float x) { return __int_as_float(__builtin_amdgcn_update_dpp(0, __float_as_int(x), 0x12F, 0xf, 0xf, false)); }
    static __device__ __forceinline__ float shr1w(float x, float w) { return __int_as_float(__builtin_amdgcn_update_dpp(__float_as_int(w), __float_as_int(x), 0x111, 0xf, 0xf, false)); }
    static __device__ __forceinline__ float shl1w(float x, float w) { return __int_as_float(__builtin_amdgcn_update_dpp(__float_as_int(w), __float_as_int(x), 0x101, 0xf, 0xf, false)); }
    __device__ __forceinline__ void operator()(const f32x4 (&acc)[2][2][4][2], const Unit& u, int wr, int wc, int fr, int fq) const {
        const int cc = u.pn * 128 + wc * 32 + 8 * fq;
        f32x4 cw0[2], cw1[2], cw2[2], cbb[2];
#pragma unroll
        for (int n = 0; n < 2; ++n) { cw0[n] = *(const f32x4*)(cw + cc + 4 * n); cw1[n] = *(const f32x4*)(cw + 2816 + cc + 4 * n); cw2[n] = *(const f32x4*)(cw + 2 * 2816 + cc + 4 * n); cbb[n] = *(const f32x4*)(cb + cc + 4 * n); }
#pragma unroll
        for (int ai = 0; ai < 2; ++ai) {
            const int tok0 = u.pm * 248 + 62 * (2 * ai + wr) - 1;
#pragma unroll
            for (int m = 0; m < 4; ++m) {
                const int j = 16 * m + fr; const int tok = tok0 + j; const int s = tok % 4352;
                const bool pz = (s == 0 || s == 256), nz = (s == 255 || s == 4351);
                const bool edge = __any(pz || nz);
                unsigned pk[4];
#pragma unroll
                for (int n = 0; n < 2; ++n) {
                    const f32x4 w0 = cw0[n], w1 = cw1[n], w2 = cw2[n], bb = cbb[n];
                    const f32x4 g = acc[ai][1][m][n];
                    float r[4];
#pragma unroll
                    for (int e = 0; e < 4; ++e) {
                        const float ge = g[e];
                        float wp = 0.f, wn = 0.f;
                        if (m > 0) { const float gq = acc[ai][1][m > 0 ? m - 1 : 0][n][e]; wp = ror1(gq); }
                        if (m < 3) { const float gq = acc[ai][1][m < 3 ? m + 1 : 3][n][e]; wn = ror15(gq); }
                        float gp = shr1w(ge, wp), gn = shl1w(ge, wn);
                        if (edge) { gp = pz ? 0.f : gp; gn = nz ? 0.f : gn; }
                        const float gc = w0[e] * gp + w1[e] * ge + w2[e] * gn + bb[e];
                        r[e] = gc * __builtin_amdgcn_rcpf(1.f + __expf(-gc)) * acc[ai][0][m][n][e];
                    }
                    pk[2 * n] = cvt_pk_bf16(r[0], r[1]); pk[2 * n + 1] = cvt_pk_bf16(r[2], r[3]);
                }
                if (j >= 1 && j <= 62 && tok < MT) { u32x4 w; w.x = pk[0]; w.y = pk[1]; w.z = pk[2]; w.w = pk[3]; *(u32x4*)(O + (size_t)tok * 2816 + cc) = w; }
                asm volatile("" ::: "memory"); __builtin_amdgcn_sched_barrier(0);
            }
        }
    }
};
template <class Epi, class Sched, bool ALIGN_EPI = false, bool SP2 = false>
__device__ __forceinline__ void gemm_phase(PG8_LAS unsigned char* lds, const Gemm g, const Sched& S, const Epi& E) {
    const int tid = ::otid(), wid = __builtin_amdgcn_readfirstlane(tid >> 6), lane = tid & 63, wr = wid >> 2, wc = wid & 3, fr = lane & 15, fq = lane >> 4;
    const int K = g.K, nt = K / BK;
    unsigned voffA[2], voffB[2];
#pragma unroll
    for (int i = 0; i < 2; ++i) { int R, C; stage_rc(tid * 16 + i * 8192, R, C); const int Rb = Epi::PERM ? ((R & ~31) + perm32(R & 31)) : R;
        voffA[i] = (unsigned)((R - g.a_skip * (R >> 6)) * K + C) * 2u; voffB[i] = (unsigned)(Rb * K + C) * 2u; }
    const size_t kstep = (size_t)(BK * 2);
    const size_t hstep = (size_t)HALF * K * 2;
    const size_t tstep = 2 * hstep; const size_t hstepA = (size_t)(HALF - 2 * g.a_skip) * K * 2, tstepA = 2 * hstepA;
    const unsigned ldsw = (unsigned)wid * 1024u;
    const int aoff = lds_byte(wr * 64 + fr, fq * 8), boff = lds_byte(wc * 32 + fr, fq * 8);
#define PG8_SA(b, h) (((b) * 2 + (h)) * HTB)
#define PG8_SB(b, h) ((4 + (b) * 2 + (h)) * HTB)
#define PG8_STAGE(bufoff, gbase, voff) do { _Pragma("unroll") for (int _i = 0; _i < 2; ++_i) \
        __builtin_amdgcn_global_load_lds((const unsigned*)((const char*)(gbase) + (voff)[_i]), (PG8_LAS unsigned*)(lds + (bufoff) + ldsw + _i * 8192), 16, 0, 0); } while (0)
#define PG8_LDA(dst, b, h) do { _Pragma("unroll") for (int m = 0; m < 4; ++m) _Pragma("unroll") for (int k = 0; k < 2; ++k) dst[m][k] = *(const PG8_LAS bf16x8*)(lds + PG8_SA(b, h) + aoff + m * 2048 + k * 1024); } while (0)
#define PG8_LDB(dst, b, h) do { _Pragma("unroll") for (int n = 0; n < 2; ++n) _Pragma("unroll") for (int k = 0; k < 2; ++k) dst[n][k] = *(const PG8_LAS bf16x8*)(lds + PG8_SB(b, h) + boff + n * 2048 + k * 1024); } while (0)
#define PG8_MMA(ai, bj, At, Bt) do { __builtin_amdgcn_s_setprio(1); _Pragma("unroll") for (int m = 0; m < 4; ++m) _Pragma("unroll") for (int n = 0; n < 2; ++n) _Pragma("unroll") for (int k = 0; k < 2; ++k) \
        acc[ai][bj][m][n] = __builtin_amdgcn_mfma_f32_16x16x32_bf16(Bt[n][k], At[m][k], acc[ai][bj][m][n], 0, 0, 0); __builtin_amdgcn_s_setprio(0); } while (0)
#define PG8_WAIT_V(n) asm volatile("s_waitcnt vmcnt(" #n ")" ::: "memory")
#define PG8_WAIT_L(n) asm volatile("s_waitcnt lgkmcnt(" #n ")" ::: "memory")
#define PG8_BAR __builtin_amdgcn_s_barrier()
#define PG8_SCHED __builtin_amdgcn_sched_barrier(0)
    Unit cur, nxt; int ui = 0;
    if (!S.next(0, cur)) return;
    f32x4 acc[2][2][4][2];
#pragma unroll
    for (int a = 0; a < 2; ++a)
#pragma unroll
        for (int b = 0; b < 2; ++b)
#pragma unroll
            for (int m = 0; m < 4; ++m)
#pragma unroll
                for (int n = 0; n < 2; ++n) acc[a][b][m][n] = (f32x4){0.f, 0.f, 0.f, 0.f};
    bf16x8 At[4][2], B0[2][2], B1[2][2];
    const char* cA = (const char*)g.A + (size_t)cur.pm * tstepA; const char* cB = (const char*)g.Bt + (size_t)cur.pn * tstep;
    S.a_ready(cur);
    if constexpr (SP2) {
        PG8_STAGE(PG8_SB(0, 0), cB, voffB); PG8_STAGE(PG8_SB(0, 1), cB + hstep, voffB); PG8_STAGE(PG8_SA(0, 0), cA, voffA); PG8_STAGE(PG8_SA(0, 1), cA + hstepA, voffA);
        if (wr == 1) PG8_BAR;
        PG8_WAIT_V(2); PG8_BAR;
        PG8_STAGE(PG8_SB(1, 0), cB + kstep, voffB); PG8_STAGE(PG8_SA(1, 0), cA + kstep, voffA); PG8_STAGE(PG8_SB(1, 1), cB + hstep + kstep, voffB);
        PG8_WAIT_V(6); PG8_BAR;
    } else {
        PG8_STAGE(PG8_SB(0, 0), cB, voffB); PG8_STAGE(PG8_SA(0, 0), cA, voffA); PG8_STAGE(PG8_SB(0, 1), cB + hstep, voffB); PG8_STAGE(PG8_SA(0, 1), cA + hstepA, voffA);
        if (wr == 1) PG8_BAR;
        PG8_WAIT_V(4); PG8_BAR;
        PG8_STAGE(PG8_SB(1, 0), cB + kstep, voffB); PG8_STAGE(PG8_SA(1, 0), cA + kstep, voffA); PG8_STAGE(PG8_SB(1, 1), cB + hstep + kstep, voffB);
        PG8_WAIT_V(6); PG8_BAR;
    }
    for (;;) {
        const bool has_next = S.next(ui + 1, nxt);
        const char* nA = has_next ? (const char*)g.A + (size_t)nxt.pm * tstepA : cA; const char* nB = has_next ? (const char*)g.Bt + (size_t)nxt.pn * tstep : cB;
        for (int t = 0; t < nt; t += 2) {
            const bool last = (t == nt - 2);
            const char* a1 = cA + (size_t)(t + 1) * kstep;
            const char* a2 = last ? nA : cA + (size_t)(t + 2) * kstep; const char* b2 = last ? nB : cB + (size_t)(t + 2) * kstep;
            const char* a3 = a2 + kstep; const char* b3 = b2 + kstep;
            if (last && has_next) S.a_ready(nxt);
            if constexpr (SP2) {
            PG8_LDB(B0, 0, 0); PG8_LDB(B1, 0, 1); PG8_SCHED; PG8_LDA(At, 0, 0); PG8_STAGE(PG8_SA(1, 1), a1 + hstepA, voffA);
            PG8_WAIT_V(8); PG8_WAIT_L(0); PG8_BAR; PG8_MMA(0, 0, At, B0); PG8_MMA(0, 1, At, B1); PG8_BAR; PG8_SCHED;
            PG8_LDA(At, 0, 1); PG8_STAGE(PG8_SB(0, 0), b2, voffB); PG8_STAGE(PG8_SB(0, 1), b2 + hstep, voffB); PG8_STAGE(PG8_SA(0, 0), a2, voffA);
            PG8_WAIT_V(8); PG8_WAIT_L(0); PG8_BAR; PG8_MMA(1, 0, At, B0); PG8_MMA(1, 1, At, B1); PG8_BAR; PG8_SCHED;
            PG8_LDB(B0, 1, 0); PG8_LDB(B1, 1, 1); PG8_SCHED; PG8_LDA(At, 1, 0); PG8_STAGE(PG8_SA(0, 1), a2 + hstepA, voffA);
            PG8_WAIT_V(8); PG8_WAIT_L(0); PG8_BAR; PG8_MMA(0, 0, At, B0); PG8_MMA(0, 1, At, B1); PG8_BAR; PG8_SCHED;
            PG8_LDA(At, 1, 1); PG8_STAGE(PG8_SB(1, 0), b3, voffB); PG8_STAGE(PG8_SB(1, 1), b3 + hstep, voffB); PG8_STAGE(PG8_SA(1, 0), a3, voffA);
            PG8_WAIT_V(8); PG8_WAIT_L(0); PG8_BAR; PG8_MMA(1, 0, At, B0); PG8_MMA(1, 1, At, B1); PG8_BAR; PG8_SCHED;
            } else {
            PG8_LDB(B0, 0, 0); PG8_SCHED; PG8_LDA(At, 0, 0); PG8_STAGE(PG8_SA(1, 1), a1 + hstepA, voffA);
            PG8_WAIT_L(8); PG8_BAR; PG8_WAIT_L(0); PG8_MMA(0, 0, At, B0); PG8_BAR; PG8_SCHED;
            PG8_LDB(B1, 0, 1); PG8_STAGE(PG8_SB(0, 0), b2, voffB);
            PG8_BAR; PG8_WAIT_L(0); PG8_MMA(0, 1, At, B1); PG8_BAR;
            PG8_LDA(At, 0, 1); PG8_STAGE(PG8_SA(0, 0), a2, voffA);
            PG8_BAR; PG8_WAIT_L(0); PG8_MMA(1, 0, At, B0); PG8_BAR; PG8_SCHED;
            PG8_STAGE(PG8_SB(0, 1), b2 + hstep, voffB);
            PG8_WAIT_V(6); PG8_BAR; PG8_MMA(1, 1, At, B1); PG8_BAR;
            PG8_LDB(B0, 1, 0); PG8_SCHED; PG8_LDA(At, 1, 0); PG8_STAGE(PG8_SA(0, 1), a2 + hstepA, voffA);
            PG8_WAIT_L(8); PG8_BAR; PG8_WAIT_L(0); PG8_MMA(0, 0, At, B0); PG8_BAR; PG8_SCHED;
            PG8_LDB(B1, 1, 1); PG8_STAGE(PG8_SB(1, 0), b3, voffB);
            PG8_BAR; PG8_WAIT_L(0); PG8_MMA(0, 1, At, B1); PG8_BAR;
            PG8_LDA(At, 1, 1); PG8_STAGE(PG8_SA(1, 0), a3, voffA);
            PG8_BAR; PG8_WAIT_L(0); PG8_MMA(1, 0, At, B0); PG8_BAR; PG8_SCHED;
            PG8_STAGE(PG8_SB(1, 1), b3 + hstep, voffB);
            PG8_WAIT_V(6); PG8_BAR; PG8_MMA(1, 1, At, B1); PG8_BAR;
            }
        }
        if constexpr (ALIGN_EPI) { if (wr == 0) PG8_BAR; }
        if constexpr (!Epi::AFTER_DRAIN) { E(acc, cur, wr, wc, fr, fq); S.done(cur); }
        if (!has_next) break;
#pragma unroll
        for (int a = 0; a < 2; ++a)
#pragma unroll
            for (int b = 0; b < 2; ++b)
#pragma unroll
                for (int m = 0; m < 4; ++m)
#pragma unroll
                    for (int n = 0; n < 2; ++n) acc[a][b][m][n] = (f32x4){0.f, 0.f, 0.f, 0.f};
        cur = nxt; cA = nA; cB = nB; ++ui;
        if constexpr (ALIGN_EPI) { if (wr == 1) PG8_BAR; }
    }
    PG8_WAIT_V(0);
    if constexpr (!ALIGN_EPI) { if (wr == 0) PG8_BAR; }
    PG8_BAR;
    if constexpr (Epi::AFTER_DRAIN) { E.fused(acc, cur, wr, wc, fr, fq, lds, wid, lane); S.done(cur); }
#undef PG8_SA
#undef PG8_SB
#undef PG8_STAGE
#undef PG8_LDA
#undef PG8_LDB
#undef PG8_MMA
#undef PG8_WAIT_V
#undef PG8_WAIT_L
#undef PG8_BAR
#undef PG8_SCHED
}
}
typedef unsigned short bf16;
typedef unsigned v4u __attribute__((ext_vector_type(4)));
typedef unsigned v2u __attribute__((ext_vector_type(2)));
typedef float f32x4 __attribute__((ext_vector_type(4)));
typedef float f32x16 __attribute__((ext_vector_type(16)));
typedef short bf16x8 __attribute__((ext_vector_type(8)));
constexpr int DM = 1024, NB = 16, SEQ = 4096, CTX = 256, SB = SEQ + CTX, MT = NB * SB, DEPTH = 4;
constexpr int INC = 1472, INP = 1536, DFF = 2816;
constexpr float EPS = 1e-6f;
constexpr int ZC_CKV = 0, ZC_KR = 128, ZC_GK = 160, ZC_GV = 288, ZC_LR = 544, ZC_POOL = 576, ZC_CQ = 832, ZC_GQ = 1088, ZC_OG = 1216;
constexpr int NTHREADS = 512, NWAVES = 8;
constexpr int LDS_BYTES = 147456;
constexpr size_t al256(size_t x) { return (x + 255) & ~(size_t)255; }
constexpr size_t WS_XC = 0;
constexpr size_t WS_ADAL = WS_XC + (size_t)NB * CTX * DM * 4;
constexpr size_t WS_ADAC = WS_ADAL + (size_t)DEPTH * NB * 6144 * 4;
constexpr size_t WS_ROPE = WS_ADAC + (size_t)DEPTH * 6144 * 4;
constexpr size_t WS_W = WS_ROPE + (size_t)SEQ * 16 * 2 * 4;
constexpr size_t WO_IN = 0, WO_KN = WO_IN + (size_t)INP * DM, WO_V = WO_KN + 512 * 256, WO_UQ = WO_V + 512 * 256, WO_O = WO_UQ + 768 * 256,
                 WO_UP = WO_O + (size_t)DM * DM, WO_DN = WO_UP + (size_t)2 * DFF * DM, W_LAYER_ELEMS = WO_DN + (size_t)DM * DFF;
constexpr size_t WS_H = al256(WS_W + W_LAYER_ELEMS * 2 * DEPTH);
constexpr size_t WS_Z = al256(WS_H + (size_t)(MT + 512) * DM * 2);
constexpr size_t WS_K = al256(WS_Z + (size_t)MT * INP * 2);
constexpr size_t WS_Q = al256(WS_K + (size_t)MT * 768 * 2);
constexpr size_t WS_AFF = WS_Z;
constexpr size_t WS_VT = al256(WS_Q + (size_t)MT * 768 * 2);
constexpr size_t WS_AKV = al256(WS_VT + (size_t)512 * MT * 2);
constexpr size_t WS_AQ = al256(WS_AKV + (size_t)MT * 256 * 2);
constexpr size_t WS_GKV = al256(WS_AQ + (size_t)MT * 256 * 2);
constexpr size_t WS_GDC = al256(WS_GKV + (size_t)128 * 68 * 2048 * 4);
constexpr size_t WS_DIAG = al256(WS_GDC + (size_t)128 * 68 * 32 * 4);
constexpr size_t WS_BAR = WS_DIAG + 256;
constexpr size_t WS_DIAG2 = WS_BAR + 16384;
constexpr size_t WS_END = WS_DIAG2 + 4096;
static_assert(WS_AFF + (size_t)MT * DFF * 2 <= WS_VT, "A_ff overlay");
static_assert(WS_END <= (size_t)1 << 30, "workspace");

struct Params {
    const float *x, *c, *ctx, *c_ctx, *w_ada, *b_ada, *norm1, *norm2, *w_in, *q_norm, *w_uq, *kv_norm, *w_ukv, *w_gk_f, *b_gk_f, *w_gk_b, *b_gk_b,
                *gla_norm, *w_pool, *pool_scale, *w_o, *w_up, *conv_w, *conv_b, *w_down, *norm_f;
    float* out; unsigned char* ws;
};

typedef const __attribute__((address_space(4))) Params* PP;
#define LDS_WAIT() asm volatile("s_waitcnt lgkmcnt(0)" ::: "memory")
__device__ __forceinline__ float bf2f(unsigned short h) { return __builtin_bit_cast(float, (unsigned)h << 16); }
__device__ __forceinline__ float bflo(unsigned w) { return __builtin_bit_cast(float, w << 16); }
__device__ __forceinline__ float bfhi(unsigned w) { return __builtin_bit_cast(float, w & 0xffff0000u); }
__device__ __forceinline__ unsigned pk2(float lo, float hi) { return pg8::cvt_pk_bf16(lo, hi); }
__device__ __forceinline__ float wave_sum(float v, int lane) {
#pragma unroll
    for (int o = 1; o < 64; o <<= 1) v += shx(v, o, lane);
    return v;
}
__device__ __forceinline__ float silu_f(float x) { return x / (1.f + __expf(-x)); }
__device__ __forceinline__ float logsig_f(float x) { return fminf(x, 0.f) - log1pf(__expf(-fabsf(x))); }

__device__ __forceinline__ const float* xin_row(PP p, int layer, int m) {
    const int b = m / SB, s = m % SB;
    if (s < CTX) return (layer == 0 ? p->ctx : (const float*)(p->ws + WS_XC)) + ((size_t)b * CTX + s) * DM;
    return (layer == 0 ? p->x : (const float*)p->out) + ((size_t)b * SEQ + (s - CTX)) * DM;
}
__device__ __forceinline__ const float* xcur_row(PP p, int m) {
    const int b = m / SB, s = m % SB;
    if (s < CTX) return (const float*)(p->ws + WS_XC) + ((size_t)b * CTX + s) * DM;
    return (const float*)p->out + ((size_t)b * SEQ + (s - CTX)) * DM;
}

__device__ __forceinline__ void tr_write(const float* scr, bf16* WT, size_t ldk, int row0, int k0, int lane) {
    const int c = lane & 7;
#pragma unroll
    for (int j = 0; j < 4; ++j) { const int n = (lane >> 3) + 8 * j; const float* s = scr + (8 * c) * 33 + n;
        v4u o; o.x = pk2(s[0 * 33], s[1 * 33]); o.y = pk2(s[2 * 33], s[3 * 33]); o.z = pk2(s[4 * 33], s[5 * 33]); o.w = pk2(s[6 * 33], s[7 * 33]);
        *(v4u*)(WT + (size_t)(row0 + n) * ldk + k0 + 8 * c) = o; }
    LDS_WAIT(); __builtin_amdgcn_wave_barrier();
}
__device__ __forceinline__ void tr_item(const float* W, int ldn, int src_n0, int k0, bf16* WT, size_t ldk, int row0, float* scr, int lane) {
#pragma unroll 8
    for (int i = 0; i < 32; ++i) { const int kk = 2 * i + (lane >> 5); scr[kk * 33 + (lane & 31)] = W[(size_t)(k0 + kk) * ldn + src_n0 + (lane & 31)]; }
    LDS_WAIT(); __builtin_amdgcn_wave_barrier();
    tr_write(scr, WT, ldk, row0, k0, lane);
}
__device__ __forceinline__ void phase_s0(PP p, unsigned char* lds) {
    const int tid = otid(), lane = tid & 63, wave = tid >> 6;
    {
        float* scr = (float*)(lds + wave * 16384);
        const int gw = obid() * NWAVES + wave, NGW = gridDim.x * NWAVES;
        constexpr int I_IN = 16 * 46, I_INZ = 64, I_UQ = 4 * 24, I_KN = 32, I_V = 32, I_PADZ = 64, I_O = 12 * 32, I_OF = 128, I_UP = 16 * 176, I_DN = 44 * 32;
        constexpr int PER_LAYER = I_IN + I_INZ + I_UQ + I_KN + I_V + I_PADZ + I_O + I_OF + I_UP + I_DN;
        for (int it = gw; it < PER_LAYER * DEPTH; it += NGW) {
            const int L = it / PER_LAYER; int r = it % PER_LAYER;
            bf16* WL = (bf16*)(p->ws + WS_W) + (size_t)L * W_LAYER_ELEMS;
            if (r < I_IN) { const int kb = r / 46, nb = r % 46; tr_item(p->w_in + (size_t)L * DM * INC, INC, nb * 32, kb * 64, WL + WO_IN, DM, nb * 32, scr, lane); continue; } r -= I_IN;
            if (r < I_INZ) { v4u z = {0u, 0u, 0u, 0u}; bf16* row = WL + WO_IN + (size_t)(INC + r) * DM; *(v4u*)(row + lane * 16) = z; *(v4u*)(row + lane * 16 + 8) = z; continue; } r -= I_INZ;
            if (r < I_UQ) { const int kb = r / 24, nb = r % 24; tr_item(p->w_uq + (size_t)L * 256 * 768, 768, nb * 32, kb * 64, WL + WO_UQ, 256, nb * 32, scr, lane); continue; } r -= I_UQ;
            if (r < I_KN) { const int kb = r / 16, nb = r % 16; tr_item(p->w_ukv + (size_t)L * 128 * 1024, 1024, (nb >> 1) * 128 + (nb & 1) * 32, kb * 64, WL + WO_KN, 256, nb * 32, scr, lane); continue; } r -= I_KN;
            if (r < I_V) { const int kb = r / 16, nb = r % 16; tr_item(p->w_ukv + (size_t)L * 128 * 1024, 1024, (nb >> 1) * 128 + 64 + (nb & 1) * 32, kb * 64, WL + WO_V, 256, nb * 32, scr, lane); continue; } r -= I_V;
            if (r < I_PADZ) {
                const int row = r * 16 + (lane >> 2); bf16* dst = WL + WO_KN + (size_t)row * 256 + 128 + (lane & 3) * 32; v4u z = {0u, 0u, 0u, 0u};
                *(v4u*)(dst) = z; *(v4u*)(dst + 8) = z; *(v4u*)(dst + 16) = z; *(v4u*)(dst + 24) = z; continue; } r -= I_PADZ;
            if (r < I_O) { const int kb = 4 + r / 32, nb = r % 32; tr_item(p->w_o + (size_t)L * DM * DM, DM, nb * 32, kb * 64, WL + WO_O, DM, nb * 32, scr, lane); continue; } r -= I_O;
            if (r < I_OF) {
                const int g = r / 32, nb = r % 32, n = lane & 31, ch = lane >> 5;
                const float* wo = p->w_o + (size_t)L * DM * DM + (size_t)(g * 64) * DM + nb * 32 + n;
                const float* ps = p->pool_scale + L * 256 + g * 64;
                const float* wp = p->w_pool + (size_t)L * 4 * 64 * 64 + (size_t)g * 64 * 64;
                for (int ci = 0; ci < 32; ++ci) { const int c = ch * 32 + ci; float a = 0.f;
                    for (int d = 0; d < 64; ++d) a += wp[c * 64 + d] * ps[d] * wo[(size_t)d * DM];
                    scr[c * 33 + n] = a; }
                LDS_WAIT(); __builtin_amdgcn_wave_barrier();
                tr_write(scr, WL + WO_O, DM, nb * 32, g * 64, lane); continue; } r -= I_OF;
            if (r < I_UP) { const int kb = r / 176, nb = r % 176, pn = nb >> 3, q = nb & 7; const int src = (q < 4) ? (128 * pn + 32 * q) : (DFF + 128 * pn + 32 * (q - 4));
                tr_item(p->w_up + (size_t)L * DM * 2 * DFF, 2 * DFF, src, kb * 64, WL + WO_UP, DM, nb * 32, scr, lane); continue; } r -= I_UP;
            { const int kb = r / 32, nb = r % 32; tr_item(p->w_down + (size_t)L * DFF * DM, DM, nb * 32, kb * 64, WL + WO_DN, DFF, nb * 32, scr, lane); }
        }
    }
    __syncthreads();
    {
        float* rope = (float*)(p->ws + WS_ROPE);
        for (int i = obid() * NTHREADS + tid; i < SEQ * 16; i += gridDim.x * NTHREADS) {
            const int pos = i >> 4, e = i & 15, axis = e >> 3, f = e & 7;
            const float inv = powf(10000.0f, -(float)f / 8.0f);
            const float ang = (float)(axis == 0 ? (pos >> 6) : (pos & 63)) * inv;
            float sn, cs; sincosf(ang, &sn, &cs);
            rope[2 * i] = cs; rope[2 * i + 1] = sn;
        }
    }
    {
        float* sc = (float*)lds;
        float* red = (float*)(lds + 17 * 1024 * 4);
        bool loaded = false;
        for (int it = obid(); it < DEPTH * 96; it += gridDim.x) {
            if (!loaded) { for (int i = tid; i < 17 * 1024; i += NTHREADS) { const float v = (i < 16 * 1024) ? p->c[i] : p->c_ctx[i - 16 * 1024]; sc[i] = silu_f(v); } loaded = true; }
            __syncthreads();
            const int L = it / 96, cb = it % 96, col = tid & 63, kg = tid >> 6;
            float acc[17];
#pragma unroll
            for (int r = 0; r < 17; ++r) acc[r] = 0.f;
            const float* w = p->w_ada + ((size_t)L * DM + kg * 128) * 6144 + cb * 64 + col;
            for (int k = 0; k < 128; ++k) { const float wv = w[(size_t)k * 6144];
#pragma unroll
                for (int r = 0; r < 17; ++r) acc[r] += sc[r * 1024 + kg * 128 + k] * wv; }
#pragma unroll
            for (int r = 0; r < 17; ++r) red[(kg * 17 + r) * 64 + col] = acc[r];
            __syncthreads();
            for (int o = tid; o < 17 * 64; o += NTHREADS) { const int r = o >> 6, cl = o & 63; float s = p->b_ada[L * 6144 + cb * 64 + cl];
#pragma unroll
                for (int g = 0; g < 8; ++g) s += red[(g * 17 + r) * 64 + cl];
                if (r < 16) ((float*)(p->ws + WS_ADAL))[((size_t)L * NB + r) * 6144 + cb * 64 + cl] = s;
                else ((float*)(p->ws + WS_ADAC))[(size_t)L * 6144 + cb * 64 + cl] = s; }
            __syncthreads();
        }
    }
}

__device__ __forceinline__ void phase_norm(PP p, int layer, int which) {
    const int tid_ = otid(); const int lane = tid_ & 63, wave = tid_ >> 6;
    const int gw = obid() * NWAVES + wave, NGW = gridDim.x * NWAVES;
    bf16* H = (bf16*)(p->ws + WS_H) + (size_t)256 * DM;
    const float* gn = (which ? p->norm2 : p->norm1) + layer * DM;
    f32x4 g4[4];
#pragma unroll
    for (int j = 0; j < 4; ++j) g4[j] = *(const f32x4*)(gn + 4 * lane + 256 * j);
    for (int m0 = gw; m0 < MT; m0 += 2 * NGW) {
        int mm[2]; mm[0] = m0; mm[1] = (m0 + NGW < MT) ? m0 + NGW : m0;
        f32x4 v[2][4], sh[2][4], sc[2][4]; float ss[2];
#pragma unroll
        for (int u = 0; u < 2; ++u) { const int m = mm[u]; const int b = m / SB, s = m % SB;
            const float* xr = which ? xcur_row(p, m) : xin_row(p, layer, m);
            const float* mod = (s < CTX) ? (const float*)(p->ws + WS_ADAC) + (size_t)layer * 6144 : (const float*)(p->ws + WS_ADAL) + ((size_t)layer * NB + b) * 6144;
            const float* shift = mod + (which ? 3 : 0) * DM; const float* scale = mod + (which ? 4 : 1) * DM;
#pragma unroll
            for (int j = 0; j < 4; ++j) { v[u][j] = __builtin_nontemporal_load((const f32x4*)(xr + 4 * lane + 256 * j)); sh[u][j] = *(const f32x4*)(shift + 4 * lane + 256 * j); sc[u][j] = *(const f32x4*)(scale + 4 * lane + 256 * j); } }
#pragma unroll
        for (int u = 0; u < 2; ++u) { float a = 0.f;
#pragma unroll
            for (int j = 0; j < 4; ++j) a += (v[u][j].x * v[u][j].x + v[u][j].y * v[u][j].y) + (v[u][j].z * v[u][j].z + v[u][j].w * v[u][j].w);
            ss[u] = a; }
#pragma unroll
        for (int o = 1; o < 64; o <<= 1) { ss[0] += shx(ss[0], o, lane); ss[1] += shx(ss[1], o, lane); }
#pragma unroll
        for (int u = 0; u < 2; ++u) {
            if (u == 1 && mm[1] == m0) break;
            const int m = mm[u]; const int s = m % SB;
            if (which && layer == DEPTH - 1 && s < CTX) continue;
            const float rstd = rsqrtf(ss[u] * (1.f / DM) + EPS);
#pragma unroll
            for (int j = 0; j < 4; ++j) { const int c = 4 * lane + 256 * j;
                const f32x4 h = (v[u][j] * rstd) * g4[j] * (sc[u][j] + 1.0f) + sh[u][j];
                v2u o; o.x = pk2(h.x, h.y); o.y = pk2(h.z, h.w); *(v2u*)(H + (size_t)m * DM + c) = o; }
        }
    }
}

constexpr int GL_Q = 0, GL_K = 2112, GL_BF = 4224, GL_BB = 6336, GL_OP = 0  , GL_LR = 8448, GL_V = 10496,
              GL_QE = 14592  , GL_KE = 18816  , GL_ATT = 23040  , GL_S = 31360  ;
static_assert((GL_S + 4096) * 4 <= LDS_BYTES, "GLA LDS map");
__device__ __forceinline__ f32x16 mfma_f32(float a, float b, f32x16 c) { return __builtin_amdgcn_mfma_f32_32x32x2f32(a, b, c, 0, 0, 0); }
constexpr int GL_W = 35456;
static_assert((GL_W + 1024) * 4 <= LDS_BYTES - 64, "GLA LDS map (weights)");
__device__ __forceinline__ float logsig_fast(float x) { return fminf(x, 0.f) - __logf(1.f + __expf(-fabsf(x))); }
struct GlaRegs { v2u q, k, l; v4u v, og; f32x4 s0, s1; };
__device__ __forceinline__ void gla_prefetch(PP p, GlaRegs& R, int it, bool with_q, int tid) {
    const int h = it & 3, c = (it >> 2) % 68, b = it / (68 * 4); const int m0 = b * SB + c * 64;
    const bf16* Z = (const bf16*)(p->ws + WS_Z); const int j = tid >> 3, e = tid & 7; const bf16* zr = Z + (size_t)(m0 + j) * INP;
    R.k = *(const v2u*)(zr + ZC_GK + h * 32 + e * 4); R.v = *(const v4u*)(zr + ZC_GV + h * 64 + e * 8); R.l = *(const v2u*)(zr + ZC_LR + e * 4);
    if (with_q) {
        R.q = *(const v2u*)(zr + ZC_GQ + h * 32 + e * 4); R.og = *(const v4u*)(zr + ZC_OG + h * 64 + e * 8);
        const float* KV = (const float*)(p->ws + WS_GKV);
        const int pb = (c < 4 ? 3 - c : 71 - c);
        R.s0 = *(const f32x4*)(KV + ((size_t)((b * 4 + h) * 2 + 0) * 68 + c) * 2048 + tid * 4);
        R.s1 = *(const f32x4*)(KV + ((size_t)((b * 4 + h) * 2 + 1) * 68 + pb) * 2048 + tid * 4);
    }
}
__device__ __forceinline__ void gla_stage(PP p, int layer, float* L, const GlaRegs& R, int h, int& h_ld, bool with_q, int tid) {
    const int lane = tid & 63, wave = tid >> 6; const int j = tid >> 3, e = tid & 7;
    if (h != h_ld) {
        for (int i = tid; i < 1024; i += NTHREADS) { const int dir = i >> 9, r = (i >> 5) & 15, d = i & 31; L[GL_W + i] = (dir ? p->w_gk_b : p->w_gk_f)[(size_t)layer * 16 * 128 + r * 128 + h * 32 + d]; }
        h_ld = h;
    }
    { float* d = L + GL_K + j * 33 + e * 4; d[0] = bflo(R.k.x); d[1] = bfhi(R.k.x); d[2] = bflo(R.k.y); d[3] = bfhi(R.k.y); }
    { float* d = L + GL_V + j * 64 + e * 8; d[0] = bflo(R.v.x); d[1] = bfhi(R.v.x); d[2] = bflo(R.v.y); d[3] = bfhi(R.v.y); d[4] = bflo(R.v.z); d[5] = bfhi(R.v.z); d[6] = bflo(R.v.w); d[7] = bfhi(R.v.w); }
    { float* d = L + GL_LR + j * 32 + e * 4; d[0] = bflo(R.l.x); d[1] = bfhi(R.l.x); d[2] = bflo(R.l.y); d[3] = bfhi(R.l.y); }
    if (with_q) { float* d = L + GL_Q + j * 33 + e * 4; d[0] = bflo(R.q.x); d[1] = bfhi(R.q.x); d[2] = bflo(R.q.y); d[3] = bfhi(R.q.y); }
    __syncthreads();
    {
        f32x4 af = *(const f32x4*)(p->b_gk_f + layer * 128 + h * 32 + e * 4), ab = *(const f32x4*)(p->b_gk_b + layer * 128 + h * 32 + e * 4);
#pragma unroll
        for (int r = 0; r < 16; ++r) { const float lf = L[GL_LR + j * 32 + r], lb = L[GL_LR + j * 32 + 16 + r];
            af += *(const f32x4*)(L + GL_W + r * 32 + e * 4) * lf; ab += *(const f32x4*)(L + GL_W + 512 + r * 32 + e * 4) * lb; }
#pragma unroll
        for (int d = 0; d < 4; ++d) { L[GL_BF + j * 33 + e * 4 + d] = logsig_fast(af[d]) * (1.f / 16.f); L[GL_BB + j * 33 + e * 4 + d] = logsig_fast(ab[d]) * (1.f / 16.f); }
    }
    __syncthreads();
    {
#pragma unroll 2
        for (int cc = 0; cc < 8; ++cc) { const int c = wave * 8 + cc, dir = c >> 5, d = c & 31; const int jj = dir ? 63 - lane : lane;
            float* bp = L + (dir ? GL_BB : GL_BF) + jj * 33 + d; float v = *bp;
#pragma unroll
            for (int o = 1; o < 64; o <<= 1) { const float t = shup(v, o, lane); if (lane >= o) v += t; }
            *bp = v; }
    }
    __syncthreads();
}
__device__ __forceinline__ void phase_gla_kv(PP p, int layer, unsigned char* lds) {
    float* L = (float*)lds; const int tid = otid(); const int lane = tid & 63, wave = tid >> 6, i32 = lane & 31, hi = lane >> 5;
    float* KV = (float*)(p->ws + WS_GKV); float* DC = (float*)(p->ws + WS_GDC);
    const int N = NB * 68 * 4, G = gridDim.x; int h_ld = -1;
    GlaRegs Rn; int it = obid();
    if (it < N) gla_prefetch(p, Rn, it, false, tid);
    for (; it < N; it += G) {
        const int h = it & 3, c = (it >> 2) % 68, b = it / (68 * 4);
        GlaRegs Rc = Rn;
        gla_stage(p, layer, L, Rc, h, h_ld, false, tid);
        if (it + G < N) gla_prefetch(p, Rn, it + G, false, tid);
        {
            const int j = tid >> 3, e = tid & 7;
#pragma unroll
            for (int d4 = 0; d4 < 4; ++d4) { const int d = e * 4 + d4; const float k = L[GL_K + j * 33 + d];
                L[GL_QE + j * 33 + d] = k * __expf(L[GL_BF + 63 * 33 + d] - L[GL_BF + j * 33 + d]);
                L[GL_KE + j * 33 + d] = k * __expf(L[GL_BB + d] - L[GL_BB + j * 33 + d]); }
        }
        __syncthreads();
        if (wave < 4) {
            const int dir = wave >> 1, vh = wave & 1; const float* KE = L + (dir ? GL_KE : GL_QE);
            f32x16 acc;
#pragma unroll
            for (int r = 0; r < 16; ++r) acc[r] = 0.f;
#pragma unroll 8
            for (int kk = 0; kk < 32; ++kk) { const int jx = 2 * kk + hi; acc = mfma_f32(KE[jx * 33 + i32], L[GL_V + jx * 64 + 32 * vh + i32], acc); }
            const int pos = dir ? (c < 4 ? 3 - c : 71 - c) : c; float* dst = KV + ((size_t)((b * 4 + h) * 2 + dir) * 68 + pos) * 2048 + 32 * vh + i32;
#pragma unroll
            for (int r = 0; r < 16; ++r) { const int d = (r & 3) + 8 * (r >> 2) + 4 * hi; dst[d * 64] = acc[r]; }
        } else if (wave == 4) { const int dr = lane >> 5, dd = lane & 31; const int ps = dr ? (c < 4 ? 3 - c : 71 - c) : c;
            DC[((size_t)((b * 4 + h) * 2 + dr) * 68 + ps) * 32 + dd] = __expf(dr ? L[GL_BB + dd] : L[GL_BF + 63 * 33 + dd]); }
        __syncthreads();
    }
}
__device__ __forceinline__ void phase_gla_scan(PP p) {
    float* KV = (float*)(p->ws + WS_GKV); const float* DC = (const float*)(p->ws + WS_GDC);
    const int T = gridDim.x * NTHREADS;
    for (int idx = obid() * NTHREADS + otid(); idx < 128 * 2048; idx += 2 * T) {
        int ix[2]; ix[0] = idx; ix[1] = (idx + T < 128 * 2048) ? idx + T : idx;
        float s[2] = {0.f, 0.f};
#pragma unroll 1
        for (int c2 = 0; c2 < 4; ++c2) {
            float t[2][17], dcy[2][17];
#pragma unroll
            for (int u = 0; u < 2; ++u) { const int chain = ix[u] >> 11, e = ix[u] & 2047, d = e >> 6;
                const float* kv = KV + (size_t)chain * 68 * 2048 + e; const float* dc = DC + (size_t)chain * 68 * 32 + d;
#pragma unroll
                for (int i = 0; i < 17; ++i) { t[u][i] = kv[(size_t)(c2 * 17 + i) * 2048]; dcy[u][i] = dc[(c2 * 17 + i) * 32]; } }
#pragma unroll
            for (int u = 0; u < 2; ++u) { if (u == 1 && ix[1] == idx) break;
                const int chain = ix[u] >> 11, e = ix[u] & 2047; float* kv = KV + (size_t)chain * 68 * 2048 + e;
#pragma unroll
                for (int i = 0; i < 17; ++i) { kv[(size_t)(c2 * 17 + i) * 2048] = s[u]; s[u] = dcy[u][i] * s[u] + t[u][i]; } }
        }
    }
}
__device__ __forceinline__ void phase_gla_out(PP p, int layer, unsigned char* lds) {
    float* L = (float*)lds; const int tid = otid(); const int lane = tid & 63, wave = tid >> 6, i32 = lane & 31, hi = lane >> 5;
    bf16* Y = (bf16*)(p->ws + WS_H) + (size_t)256 * DM;
    const float qs = 0.17677669529663687f;
    const int N = NB * 68 * 4, G = gridDim.x; int h_ld = -1;
    GlaRegs Rn; int it = obid();
    if (it < N) gla_prefetch(p, Rn, it, true, tid);
    for (; it < N; it += G) {
        const int h = it & 3, c = (it >> 2) % 68, b = it / (68 * 4); const int m0 = b * SB + c * 64;
        GlaRegs Rc = Rn;
        gla_stage(p, layer, L, Rc, h, h_ld, true, tid);
        if (it + G < N) gla_prefetch(p, Rn, it + G, true, tid);
        {
            const int i = tid >> 3, e = tid & 7;
#pragma unroll
            for (int dir = 0; dir < 2; ++dir) { const float* B = L + (dir ? GL_BB : GL_BF); const int mid = dir ? 31 : 32;
#pragma unroll
                for (int d4 = 0; d4 < 4; ++d4) { const int d = e * 4 + d4; const float bi = B[i * 33 + d], bm = B[mid * 33 + d];
                    L[GL_QE + dir * 2112 + i * 33 + d] = L[GL_Q + i * 33 + d] * qs * __expf(bi - bm);
                    L[GL_KE + dir * 2112 + i * 33 + d] = L[GL_K + i * 33 + d] * __expf(bm - bi); }
                { const int idx = tid * 4; const int d = idx >> 6; const f32x4 sv = dir ? Rc.s1 : Rc.s0; const float em = __expf(B[mid * 33 + d]);
                  *(f32x4*)(L + GL_S + dir * 2048 + idx) = sv * em; }
            }
        }
        __syncthreads();
        {
            const int dir = wave >> 2, ih = (wave >> 1) & 1, jh = wave & 1;
            const float* QE = L + GL_QE + dir * 2112 + (32 * ih + i32) * 33 + hi; const float* KE = L + GL_KE + dir * 2112 + (32 * jh + i32) * 33 + hi;
            f32x16 acc;
#pragma unroll
            for (int r = 0; r < 16; ++r) acc[r] = 0.f;
            const bool zero_tile = dir ? (ih == 1 && jh == 0) : (ih == 0 && jh == 1);
            if (!zero_tile) {
#pragma unroll
                for (int kk = 0; kk < 16; ++kk) acc = mfma_f32(QE[2 * kk], KE[2 * kk], acc);
            }
            float* at = L + GL_ATT + dir * 4160 + 32 * jh + i32; const int jg = 32 * jh + i32;
#pragma unroll
            for (int r = 0; r < 16; ++r) { const int ig = 32 * ih + (r & 3) + 8 * (r >> 2) + 4 * hi; const bool keep = dir ? (jg >= ig) : (jg <= ig); at[ig * 65] = keep ? acc[r] : 0.f; }
        }
        __syncthreads();
        {
            const int dir = wave >> 2, ih = (wave >> 1) & 1, vh = wave & 1;
            const float* AT = L + GL_ATT + dir * 4160 + (32 * ih + i32) * 65 + hi; const float* V = L + GL_V + hi * 64 + 32 * vh + i32;
            const float* QE = L + GL_QE + dir * 2112 + (32 * ih + i32) * 33 + hi; const float* S = L + GL_S + dir * 2048 + hi * 64 + 32 * vh + i32;
            f32x16 acc;
#pragma unroll
            for (int r = 0; r < 16; ++r) acc[r] = 0.f;
            const int k0 = (dir == 1 && ih == 1) ? 16 : 0, k1 = (dir == 0 && ih == 0) ? 16 : 32;
#pragma unroll 8
            for (int kk = k0; kk < k1; ++kk) acc = mfma_f32(AT[2 * kk], V[2 * kk * 64], acc);
#pragma unroll
            for (int kk = 0; kk < 16; ++kk) acc = mfma_f32(QE[2 * kk], S[2 * kk * 64], acc);
            float* op = L + GL_OP + dir * 4096 + 32 * vh + i32;
#pragma unroll
            for (int r = 0; r < 16; ++r) { const int ig = 32 * ih + (r & 3) + 8 * (r >> 2) + 4 * hi; op[ig * 64] = acc[r]; }
        }
        __syncthreads();
        {
            const int i = tid >> 3, v8 = (tid & 7) * 8;
            const f32x4 o0 = *(const f32x4*)(L + GL_OP + i * 64 + v8) + *(const f32x4*)(L + GL_OP + 4096 + i * 64 + v8);
            const f32x4 o1 = *(const f32x4*)(L + GL_OP + i * 64 + v8 + 4) + *(const f32x4*)(L + GL_OP + 4096 + i * 64 + v8 + 4);
            float ss = (o0.x * o0.x + o0.y * o0.y) + (o0.z * o0.z + o0.w * o0.w) + (o1.x * o1.x + o1.y * o1.y) + (o1.z * o1.z + o1.w * o1.w);
            ss += shx(ss, 1, lane); ss += shx(ss, 2, lane); ss += shx(ss, 4, lane);
            const float rstd = rsqrtf(ss * (1.f / 64.f) + EPS);
            const float* gn = p->gla_norm + layer * 64 + v8; const f32x4 g0 = *(const f32x4*)gn, g1 = *(const f32x4*)(gn + 4);
            const v4u ogw = Rc.og;
            const float og[8] = {bflo(ogw.x), bfhi(ogw.x), bflo(ogw.y), bfhi(ogw.y), bflo(ogw.z), bfhi(ogw.z), bflo(ogw.w), bfhi(ogw.w)};
            float y[8];
#pragma unroll
            for (int k = 0; k < 4; ++k) { y[k] = o0[k] * rstd * g0[k] * silu_f(og[k]); y[4 + k] = o1[k] * rstd * g1[k] * silu_f(og[4 + k]); }
            v4u w; w.x = pk2(y[0], y[1]); w.y = pk2(y[2], y[3]); w.z = pk2(y[4], y[5]); w.w = pk2(y[6], y[7]);
            *(v4u*)(Y + (size_t)(m0 + i) * DM + 768 + h * 64 + v8) = w;
        }
        __syncthreads();
    }
}

__device__ __forceinline__ void phase_prep(PP p, int layer) {
    const int tid_ = otid(); const int lane = tid_ & 63, wave = tid_ >> 6;
    const int gw = obid() * NWAVES + wave, NGW = gridDim.x * NWAVES;
    const bf16* Z = (const bf16*)(p->ws + WS_Z);
    bf16* Y = (bf16*)(p->ws + WS_H) + (size_t)256 * DM; bf16* AKV = (bf16*)(p->ws + WS_AKV); bf16* AQ = (bf16*)(p->ws + WS_AQ); bf16* Kb = (bf16*)(p->ws + WS_K);
    const float* rope = (const float*)(p->ws + WS_ROPE);
    const float kvn0 = p->kv_norm[layer * 128 + 2 * lane], kvn1 = p->kv_norm[layer * 128 + 2 * lane + 1];
    const f32x4 qn = *(const f32x4*)(p->q_norm + layer * 256 + 4 * lane);
    for (int m = gw; m < MT; m += NGW) {
        const int s = m % SB; const bool isctx = s < CTX; const int pos = isctx ? s : s - CTX, Lq = isctx ? CTX : SEQ; const int mbase = m - pos;
        const bf16* zr = Z + (size_t)m * INP;
        const unsigned wckv = *(const unsigned*)(zr + ZC_CKV + 2 * lane);
        const v2u wcq = *(const v2u*)(zr + ZC_CQ + 4 * lane);
        const int e = lane & 31; const float xv = bf2f(zr[ZC_KR + e]);
        float cs = 1.f, sn = 0.f;
        if (!isctx) { const int axis = e >> 4, f = e & 7; cs = rope[(pos * 16 + axis * 8 + f) * 2]; sn = rope[(pos * 16 + axis * 8 + f) * 2 + 1]; }
        const int g = lane >> 4, w = 2 << g; const int lo0 = pos - w / 2; const int lo = lo0 < 0 ? 0 : lo0; const int hi = (lo0 + w > Lq) ? Lq : lo0 + w;
        v2u pw[16];
#pragma unroll
        for (int r = 0; r < 16; ++r) { const int rr = lo + r; const int rc = (rr < hi) ? rr : pos; pw[r] = *(const v2u*)(Z + (size_t)(mbase + rc) * INP + ZC_POOL + 4 * lane); }
        const v2u pq = *(const v2u*)(zr + ZC_POOL + 4 * lane);
        {
            const float a = bflo(wckv), bq = bfhi(wckv);
            const float rstd = rsqrtf(wave_sum(a * a + bq * bq, lane) * (1.f / 128.f) + EPS);
            *(unsigned*)(AKV + (size_t)m * 256 + 2 * lane) = pk2(a * rstd * kvn0, bq * rstd * kvn1);
            *(unsigned*)(AKV + (size_t)m * 256 + 128 + 2 * lane) = 0u;
        }
        {
            const float a0 = bflo(wcq.x), a1 = bfhi(wcq.x), a2 = bflo(wcq.y), a3 = bfhi(wcq.y);
            const float rstd = rsqrtf(wave_sum((a0 * a0 + a1 * a1) + (a2 * a2 + a3 * a3), lane) * (1.f / 256.f) + EPS);
            v2u o; o.x = pk2(a0 * rstd * qn.x, a1 * rstd * qn.y); o.y = pk2(a2 * rstd * qn.z, a3 * rstd * qn.w);
            *(v2u*)(AQ + (size_t)m * 256 + 4 * lane) = o;
        }
        {
            const float pv = shx(xv, 8, lane); const int half = (e >> 3) & 1;
            const float o = isctx ? xv : xv * cs + (half ? pv : -pv) * sn;
            const float o2 = shdn(o, 1, lane);
            if (lane < 32 && !(lane & 1)) { const unsigned wv = pk2(o, o2);
#pragma unroll
                for (int h = 0; h < 8; ++h) *(unsigned*)(Kb + (size_t)m * 768 + h * 96 + 64 + lane) = wv; }
        }
        {
            float s0 = 0.f, s1 = 0.f, s2 = 0.f, s3 = 0.f;
#pragma unroll
            for (int r = 0; r < 16; ++r) { const float k = (lo + r < hi) ? 1.f : 0.f; s0 += k * bflo(pw[r].x); s1 += k * bfhi(pw[r].x); s2 += k * bflo(pw[r].y); s3 += k * bfhi(pw[r].y); }
            const float inv = 1.f / (float)(hi - lo);
            v2u o; o.x = pk2(s0 * inv - bflo(pq.x), s1 * inv - bfhi(pq.x)); o.y = pk2(s2 * inv - bflo(pq.y), s3 * inv - bfhi(pq.y));
            *(v2u*)(Y + (size_t)m * DM + 4 * lane) = o;
        }
    }
}
typedef float f32x2_t __attribute__((ext_vector_type(2))); typedef __bf16 bf16x2_t __attribute__((ext_vector_type(2)));
__device__ __forceinline__ unsigned cvtpk(float lo, float hi) { f32x2_t v = {lo, hi}; bf16x2_t b = __builtin_convertvector(v, bf16x2_t); return __builtin_bit_cast(unsigned, b); }
#ifndef AT_VG
#define AT_VG 6
#endif
constexpr int AT_KROW = 208, AT_VROW = 144, AT_KB = 64 * AT_KROW, AT_VB = 64 * AT_VROW, AT_BUF = AT_KB + AT_VB;
__device__ __forceinline__ void phase_attn(PP p, int layer, unsigned char* lds) {
    const int tid = otid(), lane = tid & 63, wave = tid >> 6, i32 = lane & 31, hi = lane >> 5;
    const bf16* Qb = (const bf16*)(p->ws + WS_Q); const bf16* Kb = (const bf16*)(p->ws + WS_K); const bf16* Vt = (const bf16*)(p->ws + WS_VT);
    bf16* Y = (bf16*)(p->ws + WS_H) + (size_t)256 * DM; const float* rope = (const float*)(p->ws + WS_ROPE);
    const int G = gridDim.x; const int bx = obid(); const int vcu = (G % 8 == 0) ? (bx % 8) * (G / 8) + bx / 8 : bx;
    const int nunits = (layer == DEPTH - 1) ? 2048 : 2048 + 128;
    const int pi = (i32 & ~12) | ((i32 & 4) << 1) | ((i32 & 8) >> 1);
    const int kp1_i = (512 + tid) < 768 ? (512 + tid) : 767; const int kp0_row = tid / 12, kp0_c = tid % 12, kp1_row = kp1_i / 12, kp1_c = kp1_i % 12;
    const int vp_d = tid >> 3, vp_c = tid & 7;
    for (int u = vcu; u < nunits; u += G) {
        int b, h, q_m0, kv_m0, NT, qpos0; bool lat;
        if (u < 2048) { const int bh = u >> 4, qb = u & 15; b = bh >> 3; h = bh & 7; q_m0 = b * SB + CTX + qb * 256; kv_m0 = b * SB; NT = 68; qpos0 = qb * 256; lat = true; }
        else { const int uc = u - 2048; b = uc >> 3; h = uc & 7; q_m0 = b * SB; kv_m0 = b * SB; NT = 4; qpos0 = 0; lat = false; }
        const bf16* kg0 = Kb + (size_t)(kv_m0 + kp0_row) * 768 + h * 96 + kp0_c * 8;
        const bf16* kg1 = Kb + (size_t)(kv_m0 + kp1_row) * 768 + h * 96 + kp1_c * 8;
        const bf16* vg = Vt + (size_t)(h * 64 + vp_d) * MT + kv_m0 + vp_c * 8;
        bf16x8 qf[6];
        v4u pr[4][3];
        {
            const int qm = q_m0 + wave * 32 + i32; const bf16* qr = Qb + (size_t)qm * 768 + h * 96 + hi * 8;
#pragma unroll
            for (int d0 = 0; d0 < 6; ++d0) qf[d0] = *(const bf16x8*)(qr + d0 * 16);
#pragma unroll
            for (int tt = 0; tt < 4; ++tt) { pr[tt][0] = *(const v4u*)(kg0 + (size_t)tt * 64 * 768); pr[tt][1] = *(const v4u*)(kg1 + (size_t)tt * 64 * 768); pr[tt][2] = *(const v4u*)(vg + tt * 64); }
        }
        {
            if (lat) {
                const int pos = qpos0 + wave * 32 + i32;
#pragma unroll
                for (int a = 0; a < 2; ++a) {
                    v4u w = __builtin_bit_cast(v4u, qf[4 + a]); v4u pw;
                    pw.x = shxu(w.x, 32, lane); pw.y = shxu(w.y, 32, lane); pw.z = shxu(w.z, 32, lane); pw.w = shxu(w.w, 32, lane);
                    const float* rp = rope + (size_t)(pos * 16 + a * 8) * 2;
                    float xv[8], pv[8], ov[8];
                    xv[0] = bflo(w.x); xv[1] = bfhi(w.x); xv[2] = bflo(w.y); xv[3] = bfhi(w.y); xv[4] = bflo(w.z); xv[5] = bfhi(w.z); xv[6] = bflo(w.w); xv[7] = bfhi(w.w);
                    pv[0] = bflo(pw.x); pv[1] = bfhi(pw.x); pv[2] = bflo(pw.y); pv[3] = bfhi(pw.y); pv[4] = bflo(pw.z); pv[5] = bfhi(pw.z); pv[6] = bflo(pw.w); pv[7] = bfhi(pw.w);
#pragma unroll
                    for (int f = 0; f < 8; ++f) { const float cs = rp[2 * f], sn = rp[2 * f + 1]; ov[f] = xv[f] * cs + (hi ? pv[f] : -pv[f]) * sn; }
                    v4u o; o.x = pk2(ov[0], ov[1]); o.y = pk2(ov[2], ov[3]); o.z = pk2(ov[4], ov[5]); o.w = pk2(ov[6], ov[7]);
                    qf[4 + a] = __builtin_bit_cast(bf16x8, o);
                }
            }
        }
        v4u rk0, rk1 = {0u, 0u, 0u, 0u}, rv, sk0, sk1 = {0u, 0u, 0u, 0u}, sv;
#define AT_LOAD(tt) do { rk0 = *(const v4u*)(kg0 + (size_t)(tt) * 64 * 768); rk1 = *(const v4u*)(kg1 + (size_t)(tt) * 64 * 768); rv = *(const v4u*)(vg + (tt) * 64); } while (0)
#define AT_LOAD2(tt) do { sk0 = *(const v4u*)(kg0 + (size_t)(tt) * 64 * 768); sk1 = *(const v4u*)(kg1 + (size_t)(tt) * 64 * 768); sv = *(const v4u*)(vg + (tt) * 64); } while (0)
#define AT_STORE2(bufi) do { unsigned char* kn_ = lds + (bufi) * AT_BUF; *(v4u*)(kn_ + kp0_row * AT_KROW + kp0_c * 16) = sk0; if (tid < 256) *(v4u*)(kn_ + kp1_row * AT_KROW + kp1_c * 16) = sk1; \
            *(v4u*)(kn_ + AT_KB + vp_d * AT_VROW + vp_c * 16) = sv; } while (0)
#define AT_STORE(bufi) do { unsigned char* kn_ = lds + (bufi) * AT_BUF; *(v4u*)(kn_ + kp0_row * AT_KROW + kp0_c * 16) = rk0; if (tid < 256) *(v4u*)(kn_ + kp1_row * AT_KROW + kp1_c * 16) = rk1; \
            *(v4u*)(kn_ + AT_KB + vp_d * AT_VROW + vp_c * 16) = rv; } while (0)
#define AT_QK(bufi, P0, P1) do { const unsigned char* ka_ = lds + (bufi) * AT_BUF + pi * AT_KROW + hi * 16; P0 = negm; P1 = negm; \
            _Pragma("unroll") for (int d0 = 0; d0 < 6; ++d0) { const bf16x8 a0 = *(const bf16x8*)(ka_ + d0 * 32); const bf16x8 a1 = *(const bf16x8*)(ka_ + 32 * AT_KROW + d0 * 32); \
                P0 = __builtin_amdgcn_mfma_f32_32x32x16_bf16(a0, qf[d0], P0, 0, 0, 0); P1 = __builtin_amdgcn_mfma_f32_32x32x16_bf16(a1, qf[d0], P1, 0, 0, 0); } } while (0)
#define AT_PV(bufi) do { const unsigned char* va_ = lds + (bufi) * AT_BUF + AT_KB + i32 * AT_VROW + hi * 16; \
            _Pragma("unroll") for (int ks = 0; ks < 4; ++ks) { const bf16x8 v0 = *(const bf16x8*)(va_ + ks * 32); const bf16x8 v1 = *(const bf16x8*)(va_ + 32 * AT_VROW + ks * 32); \
                o0 = __builtin_amdgcn_mfma_f32_32x32x16_bf16(v0, pk[ks], o0, 0, 0, 0); o1 = __builtin_amdgcn_mfma_f32_32x32x16_bf16(v1, pk[ks], o1, 0, 0, 0); } } while (0)
#define AT_SOFTMAX(FIRST, HAVE_NEXT) do { \
            f32x16 e0, e1; float rs0 = 0.f, rs1 = 0.f; \
            _Pragma("unroll") for (int r = 0; r < 16; ++r) { e0[r] = __builtin_amdgcn_exp2f(pc0[r]); e1[r] = __builtin_amdgcn_exp2f(pc1[r]); rs0 += e0[r]; rs1 += e1[r]; } \
            asm volatile("" : "+v"(e0), "+v"(e1), "+v"(rs0), "+v"(rs1)); \
            if (HAVE_NEXT) { _Pragma("unroll") for (int g_ = 0; g_ < 12; ++g_) { __builtin_amdgcn_sched_group_barrier(0x100, 1, 0); __builtin_amdgcn_sched_group_barrier(0x008, 1, 0); __builtin_amdgcn_sched_group_barrier(0x402, AT_VG, 0); } } \
              \
            if (__builtin_expect(__any((FIRST) || !(rs0 + rs1 <= 8192.0f)), 0)) { \
                float mx = fmaxf(fmaxf(pc0[0], pc1[0]), fmaxf(pc0[1], pc1[1])); \
                _Pragma("unroll") for (int r = 2; r < 16; r += 2) mx = fmaxf(mx, fmaxf(fmaxf(pc0[r], pc1[r]), fmaxf(pc0[r + 1], pc1[r + 1]))); \
                mx = fmaxf(mx, shx(mx, 32, lane)); \
                const float delta = ((FIRST) || mx > 8.0f) ? mx : 0.f; m_run += delta; const float alpha = __builtin_amdgcn_exp2f(-delta); l_run *= alpha; rs0 = 0.f; rs1 = 0.f; \
                _Pragma("unroll") for (int r = 0; r < 16; ++r) { e0[r] = __builtin_amdgcn_exp2f(pc0[r] - delta); e1[r] = __builtin_amdgcn_exp2f(pc1[r] - delta); rs0 += e0[r]; rs1 += e1[r]; \
                    o0[r] *= alpha; o1[r] *= alpha; negm[r] = -m_run; if (HAVE_NEXT) { pn0[r] -= delta; pn1[r] -= delta; } } \
            } \
            l_run += rs0 + rs1; \
            { v4u w; \
              w.x = cvtpk(e0[0], e0[1]); w.y = cvtpk(e0[2], e0[3]); w.z = cvtpk(e0[4], e0[5]); w.w = cvtpk(e0[6], e0[7]); pk[0] = __builtin_bit_cast(bf16x8, w); \
              w.x = cvtpk(e0[8], e0[9]); w.y = cvtpk(e0[10], e0[11]); w.z = cvtpk(e0[12], e0[13]); w.w = cvtpk(e0[14], e0[15]); pk[1] = __builtin_bit_cast(bf16x8, w); \
              w.x = cvtpk(e1[0], e1[1]); w.y = cvtpk(e1[2], e1[3]); w.z = cvtpk(e1[4], e1[5]); w.w = cvtpk(e1[6], e1[7]); pk[2] = __builtin_bit_cast(bf16x8, w); \
              w.x = cvtpk(e1[8], e1[9]); w.y = cvtpk(e1[10], e1[11]); w.z = cvtpk(e1[12], e1[13]); w.w = cvtpk(e1[14], e1[15]); pk[3] = __builtin_bit_cast(bf16x8, w); } \
        } while (0)
        __syncthreads();
#pragma unroll
        for (int tt = 0; tt < 4; ++tt) { rk0 = pr[tt][0]; rk1 = pr[tt][1]; rv = pr[tt][2]; AT_STORE(tt); }
        __syncthreads();
        f32x16 o0, o1, negm, pc0, pc1, pn0, pn1;
#pragma unroll
        for (int r = 0; r < 16; ++r) { o0[r] = 0.f; o1[r] = 0.f; negm[r] = 0.f; pn0[r] = 0.f; pn1[r] = 0.f; }
        float m_run = 0.f, l_run = 0.f;
        bf16x8 pk[4];
        AT_QK(0, pc0, pc1);
        {
            float mx = fmaxf(fmaxf(pc0[0], pc1[0]), fmaxf(pc0[1], pc1[1]));
#pragma unroll
            for (int r = 2; r < 16; r += 2) mx = fmaxf(mx, fmaxf(fmaxf(pc0[r], pc1[r]), fmaxf(pc0[r + 1], pc1[r + 1])));
            mx = fmaxf(mx, shx(mx, 32, lane)); m_run = mx;
#pragma unroll
            for (int r = 0; r < 16; ++r) { pc0[r] -= mx; pc1[r] -= mx; negm[r] = -mx; }
        }
        int s0 = 0;
#pragma unroll 1
        for (int tau = 0; tau < NT - 2; tau += 2) {
            const int s1 = s0 + 1, s2 = (s0 + 2 >= 6) ? s0 - 4 : s0 + 2, s4 = (s0 + 4 >= 6) ? s0 - 2 : s0 + 4;
            const int tl = (tau + 4 < NT) ? tau + 4 : NT - 2;
            AT_LOAD(tl);
            AT_QK(s1, pn0, pn1);
            AT_SOFTMAX(false, true);
            AT_PV(s0);
            pc0 = pn0; pc1 = pn1;
            AT_STORE(s4);
            AT_LOAD(tl + 1);
            AT_QK(s2, pn0, pn1);
            AT_SOFTMAX(false, true);
            AT_PV(s1);
            pc0 = pn0; pc1 = pn1;
            AT_STORE(s4 + 1);
            __syncthreads();
            s0 = s2;
        }
        {
            AT_QK(s0 + 1, pn0, pn1);
            AT_SOFTMAX(false, true);
            AT_PV(s0);
            pc0 = pn0; pc1 = pn1;
            AT_SOFTMAX(false, false);
            AT_PV(s0 + 1);
        }
#undef AT_LOAD2
#undef AT_STORE2
#undef AT_LOAD
#undef AT_STORE
#undef AT_QK
#undef AT_PV
#undef AT_SOFTMAX
        {
            const float l = l_run + shx(l_run, 32, lane); const float inv = 1.f / l;
            bf16* yr = Y + (size_t)(q_m0 + wave * 32 + i32) * DM + 256 + h * 64;
#pragma unroll
            for (int g = 0; g < 4; ++g) {
                const int d = 8 * g + 4 * hi;
                v2u w0; w0.x = pk2(o0[4 * g] * inv, o0[4 * g + 1] * inv); w0.y = pk2(o0[4 * g + 2] * inv, o0[4 * g + 3] * inv); *(v2u*)(yr + d) = w0;
                v2u w1; w1.x = pk2(o1[4 * g] * inv, o1[4 * g + 1] * inv); w1.y = pk2(o1[4 * g + 2] * inv, o1[4 * g + 3] * inv); *(v2u*)(yr + 32 + d) = w1;
            }
        }
    }
    __syncthreads();
}

__device__ __forceinline__ void phase_final(PP p) {
    const int tid_ = otid(); const int lane = tid_ & 63, wave = tid_ >> 6;
    const int gw = obid() * NWAVES + wave, NGW = gridDim.x * NWAVES;
    f32x4 g4[4];
#pragma unroll
    for (int j = 0; j < 4; ++j) g4[j] = *(const f32x4*)(p->norm_f + 4 * lane + 256 * j);
    for (int r0 = gw; r0 < NB * SEQ; r0 += 2 * NGW) {
        int rr[2]; rr[0] = r0; rr[1] = (r0 + NGW < NB * SEQ) ? r0 + NGW : r0;
        f32x4 v[2][4]; float ss[2];
#pragma unroll
        for (int u = 0; u < 2; ++u) { const float* xr = p->out + (size_t)rr[u] * DM;
#pragma unroll
            for (int j = 0; j < 4; ++j) v[u][j] = __builtin_nontemporal_load((const f32x4*)(xr + 4 * lane + 256 * j)); }
#pragma unroll
        for (int u = 0; u < 2; ++u) { float a = 0.f;
#pragma unroll
            for (int j = 0; j < 4; ++j) a += (v[u][j].x * v[u][j].x + v[u][j].y * v[u][j].y) + (v[u][j].z * v[u][j].z + v[u][j].w * v[u][j].w);
            ss[u] = a; }
#pragma unroll
        for (int o = 1; o < 64; o <<= 1) { ss[0] += shx(ss[0], o, lane); ss[1] += shx(ss[1], o, lane); }
#pragma unroll
        for (int u = 0; u < 2; ++u) {
            if (u == 1 && rr[1] == r0) break;
            float* xr = p->out + (size_t)rr[u] * DM; const float rstd = rsqrtf(ss[u] * (1.f / DM) + EPS);
#pragma unroll
            for (int j = 0; j < 4; ++j) *(f32x4*)(xr + 4 * lane + 256 * j) = v[u][j] * rstd * g4[j];
        }
    }
}


#ifdef DIAG
__device__ __forceinline__ void diag_reduce(PP p, float num, float den, unsigned char* lds) {
    float* L = (float*)lds; const int tid = otid();
    L[tid] = num; L[512 + tid] = den; __syncthreads();
    if (tid == 0) { float a = 0.f, b = 0.f; for (int i = 0; i < 512; ++i) { a += L[i]; b += L[512 + i]; } float* dg = (float*)(p->ws + WS_DIAG); dg[0] = a; dg[1] = b; }
    __syncthreads();
}
__device__ __forceinline__ void diag_ffn_up(PP p, int layer, unsigned char* lds) {
    if (obid() != 0) return;
    const int tid = otid(); float num = 0.f, den = 0.f;
    if (tid < 256) {
#ifdef DIAG_EDGE
        const int ek = (tid >> 4) & 7; const int es = ek == 0 ? 0 : ek == 1 ? 255 : ek == 2 ? 256 : ek == 3 ? 4351 : ek == 4 ? 1 : ek == 5 ? 254 : ek == 6 ? 257 : 4350;
        const int tok = (tid & 15) * SB + es, c = (tid * 97 + 5) % DFF; const int s = tok % SB;
#else
        const int tok = (tid * 271 + 13) % MT, c = (tid * 97 + 5) % DFF; const int s = tok % SB;
#endif
        const bf16* H = (const bf16*)(p->ws + WS_H) + (size_t)256 * DM; const float* W = p->w_up + (size_t)layer * DM * 2 * DFF;
        float u = 0.f, g0 = 0.f, gm = 0.f, gp = 0.f;
        for (int k = 0; k < DM; ++k) { const float wu = W[(size_t)k * 2 * DFF + c], wg = W[(size_t)k * 2 * DFF + DFF + c];
            u += bf2f(H[(size_t)tok * DM + k]) * wu; g0 += bf2f(H[(size_t)tok * DM + k]) * wg;
            if (!(s == 0 || s == 256)) gm += bf2f(H[(size_t)(tok - 1) * DM + k]) * wg;
            if (!(s == 255 || s == 4351)) gp += bf2f(H[(size_t)(tok + 1) * DM + k]) * wg; }
        const float* cw = p->conv_w + (size_t)layer * 3 * DFF; const float gc = cw[c] * gm + cw[DFF + c] * g0 + cw[2 * DFF + c] * gp + p->conv_b[layer * DFF + c];
        float ref = gc / (1.f + expf(-gc)) * u;
#ifdef UP_U
        ref = u;
#endif
#ifdef UP_G
        ref = g0;
#endif
#ifdef UP_GC
        ref = gc;
#endif
#ifdef UP_GP
        ref = gm;
#endif
#ifdef UP_GN
        ref = gp;
#endif
 const float mine = bf2f(((const bf16*)(p->ws + WS_AFF))[(size_t)tok * DFF + c]);
        num = (ref - mine) * (ref - mine); den = ref * ref;
    }
    diag_reduce(p, num, den, lds);
}
#endif

#if defined(DIAG) && DIAG == 2
__device__ __forceinline__ void diag_attn(PP p, int layer, unsigned char* lds) {
    const int tid = otid(); const int sidx = obid();
    float* L = (float*)lds;
    float* Wkv = L;
    float* qv = L + 16384;
    float* sc = L + 16384 + 128;
    float* red = L + 16384 + 128 + 4352;
    float* oacc = red + 512;
    const bf16* Z = (const bf16*)(p->ws + WS_Z); const float* rope = (const float*)(p->ws + WS_ROPE);
    #ifdef DIAG_CTX
    const int b = sidx % NB, h = (sidx / NB) % 8, pos = (sidx * 37 + 11) % CTX; const int mq = b * SB + pos; const int NK = CTX; const bool qrope = false;
#else
    const int b = sidx % NB, h = (sidx / NB) % 8, pos = (sidx * 37 + 11) % SEQ; const int mq = b * SB + CTX + pos; const int NK = SB; const bool qrope = true;
#endif
    for (int i = tid; i < 128 * 128; i += NTHREADS) Wkv[i] = p->w_ukv[(size_t)layer * 128 * 1024 + (size_t)(i >> 7) * 1024 + h * 128 + (i & 127)];
    if (tid < 96) {
        float ss = 0.f; for (int k = 0; k < 256; ++k) { const float v = bf2f(Z[(size_t)mq * INP + ZC_CQ + k]); ss += v * v; }
        const float rstd = rsqrtf(ss / 256.f + EPS); float a = 0.f;
        for (int k = 0; k < 256; ++k) a += bf2f(Z[(size_t)mq * INP + ZC_CQ + k]) * rstd * p->q_norm[layer * 256 + k] * p->w_uq[(size_t)layer * 256 * 768 + (size_t)k * 768 + h * 96 + tid];
        qv[tid] = a;
    }
    __syncthreads();
    {
        float o = 0.f;
        if (tid < 32 && qrope) { const int e = tid, axis = e >> 4, half = (e >> 3) & 1, f = e & 7; const float x = qv[64 + e], px = qv[64 + (e ^ 8)];
            const float cs = rope[(pos * 16 + axis * 8 + f) * 2], sn = rope[(pos * 16 + axis * 8 + f) * 2 + 1];
            o = x * cs + (half ? px : -px) * sn; }
        __syncthreads();
        if (tid < 32 && qrope) qv[64 + tid] = o;
    }
    __syncthreads();
    float lmax = -1e30f;
    for (int j = tid; j < NK; j += NTHREADS) {
        const bf16* zr = Z + (size_t)(b * SB + j) * INP; float ss = 0.f;
        for (int k = 0; k < 128; ++k) { const float v = bf2f(zr[ZC_CKV + k]); ss += v * v; }
        const float rstd = rsqrtf(ss / 128.f + EPS); float s = 0.f;
        for (int d = 0; d < 64; ++d) { float kn = 0.f; for (int k = 0; k < 128; ++k) kn += bf2f(zr[ZC_CKV + k]) * rstd * p->kv_norm[layer * 128 + k] * Wkv[k * 128 + d]; s += kn * qv[d]; }
        for (int e = 0; e < 32; ++e) { const int axis = e >> 4, half = (e >> 3) & 1, f = e & 7; float x = bf2f(zr[ZC_KR + e]);
            if (j >= CTX) { const int kp = j - CTX; const float px = bf2f(zr[ZC_KR + (e ^ 8)]); const float cs = rope[(kp * 16 + axis * 8 + f) * 2], sn = rope[(kp * 16 + axis * 8 + f) * 2 + 1]; x = x * cs + (half ? px : -px) * sn; }
            s += x * qv[64 + e]; }
        s *= 0.10206207261596575f; sc[j] = s; lmax = fmaxf(lmax, s);
    }
    red[tid] = lmax; __syncthreads();
    if (tid == 0) { float m = -1e30f; for (int i = 0; i < NTHREADS; ++i) m = fmaxf(m, red[i]); red[0] = m; }
    __syncthreads(); const float gmax = red[0]; __syncthreads();
    float lsum = 0.f; for (int j = tid; j < NK; j += NTHREADS) { const float e = expf(sc[j] - gmax); sc[j] = e; lsum += e; }
    red[tid] = lsum; __syncthreads();
    if (tid == 0) { float s = 0.f; for (int i = 0; i < NTHREADS; ++i) s += red[i]; red[0] = s; }
    __syncthreads(); const float gsum = red[0]; __syncthreads();
    { const int d = tid & 63, grp = tid >> 6; float o = 0.f;
      for (int j = grp; j < NK; j += 8) { const bf16* zr = Z + (size_t)(b * SB + j) * INP; float ss = 0.f;
          for (int k = 0; k < 128; ++k) { const float v = bf2f(zr[ZC_CKV + k]); ss += v * v; }
          const float rstd = rsqrtf(ss / 128.f + EPS); float vv = 0.f;
          for (int k = 0; k < 128; ++k) vv += bf2f(zr[ZC_CKV + k]) * rstd * p->kv_norm[layer * 128 + k] * Wkv[k * 128 + 64 + d];
          o += sc[j] * vv; }
      oacc[grp * 64 + d] = o; }
    __syncthreads();
    float num = 0.f, den = 0.f;
    if (tid < 64) { float o = 0.f; for (int g = 0; g < 8; ++g) o += oacc[g * 64 + tid]; o /= gsum;
        const float mine = bf2f(((const bf16*)(p->ws + WS_H) + (size_t)256 * DM)[(size_t)mq * DM + 256 + h * 64 + tid]);
        num = (o - mine) * (o - mine); den = o * o; }
    red[tid] = num; __syncthreads();
    if (tid == 0) { float s = 0.f; for (int i = 0; i < 64; ++i) s += red[i]; atomicAdd((float*)(p->ws + WS_DIAG), s); }
    __syncthreads(); red[tid] = den; __syncthreads();
    if (tid == 0) { float s = 0.f; for (int i = 0; i < 64; ++i) s += red[i]; atomicAdd((float*)(p->ws + WS_DIAG) + 1, s); }
    __syncthreads();
}
#endif

#if defined(DIAG) && DIAG == 4
__device__ __forceinline__ void diag_z(PP p, unsigned char* lds) {
    if (obid() != 0) return;
    const int tid = otid(); float num = 0.f, den = 0.f;
    {
        const int m = (tid * 1361 + 7) % MT, n = (tid * 37 + 3) % INC; const int b = m / SB, s = m % SB;
        const float* xr = (s < CTX) ? p->ctx + ((size_t)b * CTX + s) * DM : p->x + ((size_t)b * SEQ + (s - CTX)) * DM;
        const float* mod = (s < CTX) ? (const float*)(p->ws + WS_ADAC) : (const float*)(p->ws + WS_ADAL) + (size_t)b * 6144;
        float ss = 0.f; for (int k = 0; k < DM; ++k) ss += xr[k] * xr[k];
        const float rstd = 1.f / sqrtf(ss / DM + EPS); float a = 0.f;
        for (int k = 0; k < DM; ++k) { const float h = xr[k] * rstd * p->norm1[k] * (1.f + mod[DM + k]) + mod[k]; a += h * p->w_in[(size_t)k * INC + n]; }
        const float mine = bf2f(((const bf16*)(p->ws + WS_Z))[(size_t)m * INP + n]);
        num = (a - mine) * (a - mine); den = a * a;
    }
    diag_reduce(p, num, den, lds);
}
#endif
#if defined(DIAG) && DIAG == 5
__device__ __forceinline__ void diag_wo(PP p, unsigned char* lds) {
    if (obid() != 0) return;
    const int tid = otid(); float num = 0.f, den = 0.f;
    {
        const int r = (tid * 127 + 5) % (NB * SEQ), n = (tid * 37 + 3) % DM; const int b = r / SEQ, pos = r % SEQ; const int m = b * SB + CTX + pos;
        const bf16* y = (const bf16*)(p->ws + WS_H) + (size_t)256 * DM + (size_t)m * DM;
        float a = 0.f;
        for (int g = 0; g < 4; ++g) for (int d = 0; d < 64; ++d) { float yy = 0.f; for (int c = 0; c < 64; ++c) yy += bf2f(y[g * 64 + c]) * p->w_pool[(size_t)g * 4096 + c * 64 + d];
            a += yy * p->pool_scale[g * 64 + d] * p->w_o[(size_t)(g * 64 + d) * DM + n]; }
        for (int k = 256; k < DM; ++k) a += bf2f(y[k]) * p->w_o[(size_t)k * DM + n];
        const float gate = ((const float*)(p->ws + WS_ADAL))[(size_t)b * 6144 + 2 * DM + n];
        const float delta = gate * a; const float mine = p->out[(size_t)r * DM + n] - p->x[(size_t)r * DM + n];
        num = (delta - mine) * (delta - mine); den = delta * delta;
    }
    diag_reduce(p, num, den, lds);
}
#endif

#if defined(DIAG) && DIAG == 6
__device__ __forceinline__ void diag_ada(PP p, unsigned char* lds) {
    if (obid() != 0) return;
    const int tid = otid(); float num = 0.f, den = 0.f;
    {
        const int L = tid & 3, r = (tid >> 2) % 17, j = (tid * 193 + 11) % 6144;
        float a = p->b_ada[L * 6144 + j], comp = 0.f;
        for (int k = 0; k < DM; ++k) { const float cv = (r < 16) ? p->c[r * DM + k] : p->c_ctx[k]; const float sv = cv / (1.f + expf(-cv));
            const float term = sv * p->w_ada[((size_t)L * DM + k) * 6144 + j]; const float y = term - comp; const float tt = a + y; comp = (tt - a) - y; a = tt; }
        const float mine = (r < 16) ? ((const float*)(p->ws + WS_ADAL))[((size_t)L * NB + r) * 6144 + j] : ((const float*)(p->ws + WS_ADAC))[(size_t)L * 6144 + j];
        num = (a - mine) * (a - mine); den = a * a;
    }
    diag_reduce(p, num, den, lds);
}
#endif

#if defined(DIAG) && DIAG == 7
__device__ __forceinline__ void diag_pool(PP p, unsigned char* lds) {
    if (obid() != 0) return;
    const int tid = otid(); float num = 0.f, den = 0.f;
    {
        const int b = tid & 15; const int k = (tid >> 4) & 31; const int ch = (tid * 37 + 5) & 255;
        const int svals[32] = {0, 1, 2, 3, 7, 8, 9, 15, 16, 100, 246, 247, 248, 253, 254, 255, 256, 257, 258, 263, 264, 265, 272, 1000, 2000, 3000, 4336, 4343, 4344, 4349, 4350, 4351};
        int s = 0;
#pragma unroll
        for (int i = 0; i < 32; ++i) if (i == k) s = svals[i];
        const int m = b * SB + s; const bool isctx = s < CTX; const int pos = isctx ? s : s - CTX, Lq = isctx ? CTX : SEQ, mbase = m - pos;
        const int g = ch >> 6, w = 2 << g; int lo = pos - w / 2, hi = lo + w; lo = lo < 0 ? 0 : lo; hi = hi > Lq ? Lq : hi;
        const bf16* Z = (const bf16*)(p->ws + WS_Z);
        float sum = 0.f; for (int r = lo; r < hi; ++r) sum += bf2f(Z[(size_t)(mbase + r) * INP + ZC_POOL + ch]);
        const float ref = sum / (float)(hi - lo) - bf2f(Z[(size_t)m * INP + ZC_POOL + ch]);
        const float mine = bf2f(((const bf16*)(p->ws + WS_H) + (size_t)256 * DM)[(size_t)m * DM + ch]);
        num = (ref - mine) * (ref - mine); den = ref * ref;
    }
    diag_reduce(p, num, den, lds);
}
#endif

#if defined(DIAG) && DIAG == 8
__device__ __forceinline__ void diag_down_a(PP p, int layer) {
    if (obid() != 0) return;
    const int tid = otid();
    const int r = (tid * 127 + 5) % (NB * SEQ), n = (tid * 37 + 3) % DM; const int b = r / SEQ, pos = r % SEQ; const int m = b * SB + CTX + pos;
    const bf16* a = (const bf16*)(p->ws + WS_AFF) + (size_t)m * DFF; const float* W = p->w_down + (size_t)layer * DFF * DM;
    float acc = 0.f; for (int k = 0; k < DFF; ++k) acc += bf2f(a[k]) * W[(size_t)k * DM + n];
    const float gate = ((const float*)(p->ws + WS_ADAL))[((size_t)layer * NB + b) * 6144 + 5 * DM + n];
    ((float*)(p->ws + WS_DIAG2))[tid] = gate * acc; ((float*)(p->ws + WS_DIAG2))[512 + tid] = p->out[(size_t)r * DM + n];
}
__device__ __forceinline__ void diag_down_b(PP p, unsigned char* lds) {
    if (obid() != 0) return;
    const int tid = otid();
    const int r = (tid * 127 + 5) % (NB * SEQ), n = (tid * 37 + 3) % DM;
    const float delta = ((const float*)(p->ws + WS_DIAG2))[tid], x1 = ((const float*)(p->ws + WS_DIAG2))[512 + tid];
    const float mine = p->out[(size_t)r * DM + n] - x1;
    diag_reduce(p, (delta - mine) * (delta - mine), delta * delta, lds);
}
#endif
#ifndef WO_SCALE
#define WO_SCALE 1.f
#endif
#ifndef DN_SCALE
#define DN_SCALE 1.f
#endif
#define LAS __attribute__((address_space(3)))
#define XB_TMO      128
#define XB_XCNT(j)  (256  + 64 * (j))
#define XB_XSUB(j)  (1280 + 64 * (j))
#define XB_XGEN(j)  (2304 + 64 * (j))
#define XB_TOP      3328
#define XB_TOPGEN   3392
#define XCD_BAR_WORDS 3456
#define XB_SPIN_CAP (1u << 18)

__device__ __forceinline__ unsigned xb_ld(unsigned* p)              { return __hip_atomic_load(p, __ATOMIC_RELAXED, __HIP_MEMORY_SCOPE_AGENT); }
__device__ __forceinline__ unsigned xb_add(unsigned* p, unsigned v) { return __hip_atomic_fetch_add(p, v, __ATOMIC_RELAXED, __HIP_MEMORY_SCOPE_AGENT); }
__device__ __forceinline__ unsigned xb_xcc_id() { return (unsigned)__builtin_amdgcn_s_getreg((3 << 11) | 20) & 0xFu; }
#define XB_SPIN(cond, bar) do { unsigned _sp = 0; while (cond) { __builtin_amdgcn_s_sleep(1); \
    if ((++_sp & 255u) == 0u) { if (xb_ld(&(bar)[XB_TMO])) break; if (_sp > XB_SPIN_CAP) { atomicAdd(&(bar)[XB_TMO], 1u); break; } } } } while (0)

struct XcdBarrier {
    unsigned* bar; unsigned x;
    volatile LAS unsigned* st;
};

__device__ __forceinline__ XcdBarrier xcd_barrier_post(unsigned* bar, volatile LAS unsigned* st) {
    XcdBarrier b; b.bar = bar; b.x = xb_xcc_id(); b.st = st;
    if (threadIdx.x == 0) (void)xb_add(&bar[XB_XCNT(b.x)], 1u);
    return b;
}
__device__ __forceinline__ void xcd_barrier_complete(unsigned* bar, unsigned x, unsigned& nloc, unsigned& nx) {
    const unsigned G = gridDim.x * gridDim.y * gridDim.z;
    unsigned sum, cnt, mine, sp = 0u;
    for (;;) {
        sum = 0u; cnt = 0u; mine = 0u;
#pragma unroll
        for (unsigned j = 0; j < 16; ++j) { const unsigned c = xb_ld(&bar[XB_XCNT(j)]); sum += c; cnt += (c > 0u) ? 1u : 0u; mine = (j == x) ? c : mine; }
        if (sum == G) break;
        __builtin_amdgcn_s_sleep(1);
        if ((++sp & 255u) == 0u) { if (xb_ld(&bar[XB_TMO])) break; if (sp > XB_SPIN_CAP) { atomicAdd(&bar[XB_TMO], 1u); break; } }
    }
    nloc = mine > 0u ? mine : 1u; nx = cnt > 0u ? cnt : 1u;
}

__device__ __forceinline__ void xcd_barrier(const XcdBarrier& b) {
    asm volatile("s_waitcnt vmcnt(0)" ::: "memory");
    __syncthreads();
    if (threadIdx.x == 0) {
        unsigned* bar = b.bar;
        __builtin_amdgcn_s_waitcnt(0);
        unsigned nloc = b.st[0], nx = b.st[1];
        if (nloc == 0u) { xcd_barrier_complete(bar, b.x, nloc, nx); b.st[0] = nloc; b.st[1] = nx; }
        const unsigned old = xb_add(&bar[XB_XSUB(b.x)], 1u);
        const unsigned gen = old / nloc;
        if (old + 1u == (gen + 1u) * nloc) {
            __builtin_amdgcn_fence(__ATOMIC_RELEASE, "agent");
            asm volatile("s_waitcnt vmcnt(0)" ::: "memory");
            const unsigned og = xb_add(&bar[XB_TOP], 1u);
            const unsigned tg = og / nx;
            if (og + 1u == (tg + 1u) * nx) xb_add(&bar[XB_TOPGEN], 1u);
            else XB_SPIN(xb_ld(&bar[XB_TOPGEN]) == tg, bar);
            __builtin_amdgcn_fence(__ATOMIC_ACQUIRE, "agent");
            xb_add(&bar[XB_XGEN(b.x)], 1u);
            asm volatile("s_waitcnt vmcnt(0)" ::: "memory");
        } else {
            XB_SPIN(xb_ld(&bar[XB_XGEN(b.x)]) == gen, bar);
            __builtin_amdgcn_fence(__ATOMIC_ACQUIRE, "agent");
            asm volatile("s_waitcnt vmcnt(0)" ::: "memory");
        }
    }
    __syncthreads();
}

#define LAUNDER() asm volatile("" : "+s"(p) :: "memory")
__global__ void __launch_bounds__(NTHREADS, 2) fwd_megakernel(Params p_unused) {
    extern __shared__ __attribute__((aligned(16))) unsigned char lds[];
    PP p = (PP)__builtin_amdgcn_kernarg_segment_ptr(); LAUNDER();
    { volatile LAS unsigned* misc = (volatile LAS unsigned*)((LAS unsigned char*)lds + LDS_BYTES - 64); if (otid() < 16) misc[otid()] = 0u; __syncthreads(); }
    (void)xcd_barrier_post((unsigned*)(p->ws + WS_BAR), (volatile LAS unsigned*)((LAS unsigned char*)lds + LDS_BYTES - 64));
    if (gridDim.x == 0xffffffffu) cg::this_grid().sync();
#define WLP(off) ((const pg8::bf16_t*)(p->ws + WS_W) + (size_t)layer * W_LAYER_ELEMS + (off))
#define HP ((pg8::bf16_t*)(p->ws + WS_H) + (size_t)256 * DM)
#define LDSL ((PG8_LAS unsigned char*)lds)
#define GBAR() do { XcdBarrier xb_; xb_.bar = (unsigned*)(p->ws + WS_BAR); xb_.x = xb_xcc_id(); xb_.st = (volatile LAS unsigned*)((LAS unsigned char*)lds + LDS_BYTES - 64); xcd_barrier(xb_); } while (0)
#ifdef REP_SYNC
#define SYNC() do { GBAR(); GBAR(); GBAR(); LAUNDER(); } while (0)
#elif defined(CG_SYNC)
#define SYNC() do { cg::this_grid().sync(); LAUNDER(); } while (0)
#else
#define SYNC() do { GBAR(); LAUNDER(); } while (0)
#endif
#if defined(DIAG) && DIAG == 3
#define STAMP(k) do { if (layer == 1 && obid() == 0 && otid() == 0) ((unsigned long long*)(p->ws + WS_DIAG + 64))[k] = __builtin_amdgcn_s_memrealtime(); } while (0)
#else
#define STAMP(k) do {} while (0)
#endif
#ifdef DIAG
    if (obid() == 0 && otid() < 8) ((float*)(p->ws + WS_DIAG))[otid()] = 0.f;
#endif
#ifndef SK_S0
    phase_s0(p, lds);
#ifdef REP_S0
    LAUNDER(); __syncthreads(); phase_s0(p, lds);
#endif
#endif
    SYNC();
#if defined(DIAG) && DIAG == 6
    diag_ada(p, lds); LAUNDER(); SYNC();
#endif
#pragma nounroll
    for (int layer = 0; layer < DEPTH; ++layer) {
        STAMP(0);
#ifndef SK_NORM
        phase_norm(p, layer, 0);
#ifdef REP_NORM
        LAUNDER(); phase_norm(p, layer, 0);
#endif
#endif
        SYNC(); STAMP(1);
#ifndef SK_Z
        { pg8::Gemm g{HP, WLP(WO_IN), MT, INP, DM, 0}; pg8::StaticOrder S; S.init(MT, INP, (int)gridDim.x, obid());
          pg8::EpiBf16g E{(pg8::bf16_t*)(p->ws + WS_Z), (size_t)INP, 1.f, 30, 0};
          pg8::gemm_phase<pg8::EpiBf16g, pg8::StaticOrder, true, true>(LDSL, g, S, E);
#ifdef REP_Z
          LAUNDER(); pg8::gemm_phase<pg8::EpiBf16g, pg8::StaticOrder, true, true>(LDSL, g, S, E);
#endif
        }
#endif
        SYNC(); STAMP(2);
#if defined(DIAG) && DIAG == 4
        if (layer == 0) { diag_z(p, lds); LAUNDER(); }
#endif
#ifndef SK_PREP
        phase_prep(p, layer);
#ifdef REP_PREP
        LAUNDER(); phase_prep(p, layer);
#endif
#endif
        LAUNDER(); STAMP(3);
#ifndef SK_GKV
        phase_gla_kv(p, layer, lds);
#ifdef REP_GKV
        LAUNDER(); phase_gla_kv(p, layer, lds);
#endif
#endif
        SYNC(); STAMP(4);
#if defined(DIAG) && DIAG == 7
        if (layer == 0) { diag_pool(p, lds); LAUNDER(); SYNC(); }
#endif
#ifndef SK_S4
#ifdef REP_S4
#pragma nounroll
        for (int rep_ = 0; rep_ < 2; ++rep_)
#endif
        {
        { pg8::Gemm g{(const pg8::bf16_t*)(p->ws + WS_AKV), WLP(WO_KN), MT, 512, 256, 0}; asm volatile("" : "+s"(g.K)); pg8::StaticOrder S; S.init(MT, 512, (int)gridDim.x, obid());
          pg8::EpiBf16g E{(pg8::bf16_t*)(p->ws + WS_K), (size_t)768, 1.f, 6, 96};
          pg8::gemm_phase<pg8::EpiBf16g, pg8::StaticOrder, true, true>(LDSL, g, S, E); }
        LAUNDER(); __builtin_amdgcn_sched_barrier(0);
        { pg8::Gemm g{WLP(WO_V), (const pg8::bf16_t*)(p->ws + WS_AKV), 512, MT, 256, 0}; asm volatile("" : "+s"(g.K)); pg8::StaticOrder S; S.init(512, MT, (int)gridDim.x, obid());
          pg8::EpiBf16g E{(pg8::bf16_t*)(p->ws + WS_VT), (size_t)MT, 1.f, 30, 0};
          pg8::gemm_phase<pg8::EpiBf16g, pg8::StaticOrder, true, true>(LDSL, g, S, E); }
        LAUNDER(); __builtin_amdgcn_sched_barrier(0);
        { pg8::Gemm g{(const pg8::bf16_t*)(p->ws + WS_AQ), WLP(WO_UQ), MT, 768, 256, 0}; asm volatile("" : "+s"(g.K)); pg8::StaticOrder S; S.init(MT, 768, (int)gridDim.x, obid());
          pg8::EpiBf16g E{(pg8::bf16_t*)(p->ws + WS_Q), (size_t)768, 0.10206207261596575f * 1.4426950408889634f, 30, 0};
          pg8::gemm_phase<pg8::EpiBf16g, pg8::StaticOrder, true, true>(LDSL, g, S, E); }
        LAUNDER(); __builtin_amdgcn_sched_barrier(0);
        }
#endif
        STAMP(5);
#ifndef SK_GSCAN
        phase_gla_scan(p);
#endif
#ifdef REP_SCAN
        SYNC(); phase_gla_kv(p, layer, lds); SYNC(); phase_gla_scan(p);
#endif
        SYNC(); STAMP(6);
#ifndef SK_ATTN
        phase_attn(p, layer, lds);
#ifdef REP_ATTN
        LAUNDER(); phase_attn(p, layer, lds);
#endif
#endif
        LAUNDER(); STAMP(7);
#ifndef SK_GOUT
        phase_gla_out(p, layer, lds);
#ifdef REP_GOUT
        LAUNDER(); phase_gla_out(p, layer, lds);
#endif
#endif
        SYNC(); STAMP(8);
#if defined(DIAG) && DIAG == 2
        if (layer == DIAG_LAYER) { diag_attn(p, layer, lds); LAUNDER(); }
#endif
#ifndef SK_WO
        { pg8::Gemm g{HP, WLP(WO_O), MT, DM, DM, 0}; pg8::StaticOrder S; const int lastl = (layer == DEPTH - 1); S.init(lastl ? NB * SEQ : MT, DM, (int)gridDim.x, obid(), lastl);
          const float* adal = (const float*)(p->ws + WS_ADAL) + (size_t)layer * NB * 6144; const float* adac = (const float*)(p->ws + WS_ADAC) + (size_t)layer * 6144;
          pg8::EpiResid E{layer == 0 ? p->ctx : (const float*)(p->ws + WS_XC), layer == 0 ? p->x : (const float*)p->out, (float*)(p->ws + WS_XC), p->out, adac + 2 * DM, adal + 2 * DM};
          pg8::gemm_phase<pg8::EpiResid, pg8::StaticOrder, false, true>(LDSL, g, S, E); }
#endif
        SYNC(); STAMP(9);
#if defined(DIAG) && DIAG == 5
        if (layer == 0) { diag_wo(p, lds); LAUNDER(); SYNC(); }
#endif
#ifndef SK_NORM
        phase_norm(p, layer, 1);
#endif
        SYNC(); STAMP(10);
#ifndef SK_UP
        { pg8::Gemm g{HP - DM, WLP(WO_UP), 281 * 256, 2 * DFF, DM, 2}; pg8::StaticOrder S; S.init(281 * 256, 2 * DFF, (int)gridDim.x, obid());
          pg8::EpiUp E{(pg8::bf16_t*)(p->ws + WS_AFF), p->conv_w + (size_t)layer * 3 * DFF, p->conv_b + (size_t)layer * DFF, MT};
          pg8::gemm_phase<pg8::EpiUp, pg8::StaticOrder, true, true>(LDSL, g, S, E);
#ifdef REP_UP
          LAUNDER(); pg8::gemm_phase<pg8::EpiUp, pg8::StaticOrder, true, true>(LDSL, g, S, E);
#endif
        }
#endif
        SYNC(); STAMP(11);
#if defined(DIAG) && DIAG == 1
        if (layer == 0) { diag_ffn_up(p, layer, lds); LAUNDER(); }
#endif
#if defined(DIAG) && DIAG == 8
        if (layer == DIAG_LAYER) { diag_down_a(p, layer); LAUNDER(); SYNC(); }
#endif
#ifndef SK_DN
        { pg8::Gemm g{(const pg8::bf16_t*)(p->ws + WS_AFF), WLP(WO_DN), MT, DM, DFF, 0}; pg8::StaticOrder S; const int lastl = (layer == DEPTH - 1); S.init(lastl ? NB * SEQ : MT, DM, (int)gridDim.x, obid(), lastl);
          const float* adal = (const float*)(p->ws + WS_ADAL) + (size_t)layer * NB * 6144; const float* adac = (const float*)(p->ws + WS_ADAC) + (size_t)layer * 6144;
          pg8::EpiResid E{(const float*)(p->ws + WS_XC), (const float*)p->out, (float*)(p->ws + WS_XC), p->out, adac + 5 * DM, adal + 5 * DM};
          pg8::gemm_phase<pg8::EpiResid, pg8::StaticOrder, false, true>(LDSL, g, S, E); }
#endif
        SYNC(); STAMP(12);
#if defined(DIAG) && DIAG == 8
        if (layer == DIAG_LAYER) { diag_down_b(p, lds); LAUNDER(); SYNC(); }
#endif
    }
    phase_final(p);
#ifdef DIAG
    SYNC();
    { const float* dg = (const float*)(p->ws + WS_DIAG); float d = dg[0] / (dg[1] + 1e-30f); d = exp2f(rintf(log2f(d + 1e-12f) * 2.f) * 0.5f); float v = 1000.f * sqrtf(d);
#if DIAG == 3
      const unsigned long long* ts = (const unsigned long long*)(p->ws + WS_DIAG + 64); v = (float)(ts[DIAG_TA1] - ts[DIAG_TA0]) * 0.0001f; const float vb = (float)(ts[DIAG_TB1] - ts[DIAG_TB0]) * 0.01f;
#endif
      for (size_t i = (size_t)obid() * NTHREADS + otid(); i < (size_t)NB * SEQ * DM; i += (size_t)gridDim.x * NTHREADS) p->out[i] = v;
#if DIAG == 3
      SYNC(); if (obid() == 0 && otid() == 0) p->out[0] = vb;
#endif
    }
#endif
}

extern "C" void kernel_launch(void* const* d_in, const int* in_sizes, int n_in, void* d_out, int out_size, void* d_ws, size_t ws_size, hipStream_t stream) {
    static int grid_blocks = 0;
    if (grid_blocks == 0) {
        if (n_in != 26 || ws_size < WS_END) { fprintf(stderr, "kernel_launch: unexpected n_in %d / ws %zu (need %zu)\n", n_in, ws_size, (size_t)WS_END); grid_blocks = -1; return; }
        int dev = 0, cus = 0, per_cu = 0;
        hipGetDevice(&dev); hipDeviceGetAttribute(&cus, hipDeviceAttributeMultiprocessorCount, dev);
        if (hipFuncSetAttribute((const void*)fwd_megakernel, hipFuncAttributeMaxDynamicSharedMemorySize, LDS_BYTES) != hipSuccess) { fprintf(stderr, "kernel_launch: hipFuncSetAttribute failed\n"); grid_blocks = -1; return; }
        if (hipOccupancyMaxActiveBlocksPerMultiprocessor(&per_cu, (const void*)fwd_megakernel, NTHREADS, LDS_BYTES) != hipSuccess || per_cu < 1) { fprintf(stderr, "kernel_launch: occupancy query gave %d\n", per_cu); per_cu = 1; }
        (void)hipGetLastError();
        grid_blocks = cus * per_cu;
    }
    if (grid_blocks < 0) return;
    Params p{};
    const float** pp = (const float**)&p;
    for (int i = 0; i < 26; ++i) pp[i] = (const float*)d_in[i];
    p.out = (float*)d_out; p.ws = (unsigned char*)d_ws;
    if (hipMemsetAsync((unsigned char*)d_ws + WS_BAR, 0, 16384, stream) != hipSuccess) { fprintf(stderr, "kernel_launch: memset failed\n"); return; }
    void* args[] = {&p};
    hipError_t e = hipLaunchCooperativeKernel((const void*)fwd_megakernel, dim3(grid_blocks), dim3(NTHREADS), args, LDS_BYTES, stream);
    if (e != hipSuccess) fprintf(stderr, "cooperative launch failed: %s (grid %d)\n", hipGetErrorString(e), grid_blocks);
}
```

```cpp
#include <hip/hip_runtime.h>
#include <hip/hip_cooperative_groups.h>
#include <cstdio>
#include <cstdint>
namespace cg = cooperative_groups;
__device__ __forceinline__ int otid() { int t = threadIdx.x; asm volatile("" : "+v"(t)); return t; }
__device__ __forceinline__ int obid() { int t = blockIdx.x; asm volatile("" : "+s"(t)); return t; }
__device__ __forceinline__ float shx(float v, int o, int lane) { return __int_as_float(__builtin_amdgcn_ds_bpermute((lane ^ o) << 2, __float_as_int(v))); }
__device__ __forceinline__ unsigned shxu(unsigned v, int o, int lane) { return (unsigned)__builtin_amdgcn_ds_bpermute((lane ^ o) << 2, (int)v); }
__device__ __forceinline__ float shup(float v, int o, int lane) { return __int_as_float(__builtin_amdgcn_ds_bpermute(((lane - o) & 63) << 2, __float_as_int(v))); }
__device__ __forceinline__ float shdn(float v, int o, int lane) { return __int_as_float(__builtin_amdgcn_ds_bpermute(((lane + o) & 63) << 2, __float_as_int(v))); }
namespace pg8 {
#define PG8_LAS __attribute__((address_space(3)))
typedef unsigned short bf16_t;
typedef short bf16x8 __attribute__((ext_vector_type(8)));
typedef float f32x4 __attribute__((ext_vector_type(4)));
typedef unsigned u32x4 __attribute__((ext_vector_type(4)));
constexpr int BM = 256, BK = 64, HALF = 128, HTB = HALF * BK * 2  , STAGE_BYTES = 8 * HTB, NXCD = 8, WGM = 4;

__host__ __device__ __forceinline__ int lds_byte(int r, int c) { const int st = (r >> 4) * 2 + (c >> 5), rr = r & 15, cc = c & 31, ob = rr * 64 + cc * 2; return st * 1024 + (ob ^ (((ob >> 9) & 1) << 5)); }
__host__ __device__ __forceinline__ void stage_rc(int b, int& R, int& C) { const int st = b / 1024, sb = b % 1024, swz = sb ^ (((sb >> 9) & 1) << 5); R = (st >> 1) * 16 + swz / 64; C = (st & 1) * 32 + (swz % 64) / 2; }
__host__ __device__ __forceinline__ int perm32(int rho) { const int n = rho >> 4, i = rho & 15; return 8 * (i >> 2) + 4 * n + (i & 3); }

struct Unit { int pm, pn; };
struct Gemm { const bf16_t* A; const bf16_t* Bt; int M, N, K, a_skip; };

struct StaticOrder {
    int nM, nN, nwg, G, c, skipc;
    __host__ __device__ void init(int M, int N, int G_, int c_, int skipc_ = 0) { nM = M / BM; nN = N / BM; nwg = nM * nN; G = G_; c = c_; skipc = skipc_; }
    __host__ __device__ bool next(int i, Unit& u) const {
        const long L = (long)i * G + c; if (L >= nwg) return false;
        int wgid = (int)L; { const int q = nwg / NXCD, r = nwg % NXCD, xcd = wgid % NXCD, off = wgid / NXCD; wgid = (xcd < r ? xcd * (q + 1) : r * (q + 1) + (xcd - r) * q) + off; }
        const int nig = WGM * nN, gid = wgid / nig, fm = gid * WGM, gsz = (nM - fm) < WGM ? (nM - fm) : WGM;
        u.pm = fm + ((wgid % nig) % gsz); u.pn = (wgid % nig) / gsz; if (skipc) u.pm += u.pm / 16 + 1; return true;
    }
    __device__ __forceinline__ void a_ready(const Unit&) const {}
    __device__ __forceinline__ void done(const Unit&) const {}
};

__device__ __forceinline__ unsigned cvt_pk_bf16(float lo, float hi) { unsigned r; asm volatile("v_cvt_pk_bf16_f32 %0, %1, %2" : "=v"(r) : "v"(lo), "v"(hi)); return r; }
struct EpiBf16g {
    static constexpr bool PERM = true, AFTER_DRAIN = false;
    bf16_t* O; size_t ldc; float sc; int gshift, gout;
    __device__ __forceinline__ void operator()(const f32x4 (&acc)[2][2][4][2], const Unit& u, int wr, int wc, int fr, int fq) const {
        const int row0 = u.pm * BM + wr * 64 + fr;
        const int c0 = u.pn * BM + wc * 32 + 8 * fq;
#pragma unroll
        for (int ai = 0; ai < 2; ++ai)
#pragma unroll
            for (int m = 0; m < 4; ++m) { bf16_t* rowp = O + (size_t)(row0 + ai * HALF + m * 16) * ldc;
#pragma unroll
                for (int bj = 0; bj < 2; ++bj) { const int c = c0 + bj * HALF; const int dc = (c >> gshift) * gout + (c & ((1 << gshift) - 1));
                    f32x4 v0 = acc[ai][bj][m][0] * sc, v1 = acc[ai][bj][m][1] * sc;
                    u32x4 w; w.x = cvt_pk_bf16(v0[0], v0[1]); w.y = cvt_pk_bf16(v0[2], v0[3]); w.z = cvt_pk_bf16(v1[0], v1[1]); w.w = cvt_pk_bf16(v1[2], v1[3]);
                    *(u32x4*)(rowp + dc) = w; } }
    }
};
struct EpiResid {
    static constexpr bool PERM = false, AFTER_DRAIN = false;
    const float* base_c; const float* base_l; float* out_c; float* out_l; const float* gate_c; const float* gate_l;
    __device__ __forceinline__ void operator()(const f32x4 (&acc)[2][2][4][2], const Unit& u, int wr, int wc, int fr, int fq) const {
        const int b = u.pm / 17, tt = u.pm % 17;
        const float* base; float* out; const float* gate;
        if (tt == 0) { base = base_c + (size_t)b * 256 * 1024; out = out_c + (size_t)b * 256 * 1024; gate = gate_c; }
        else { base = base_l + ((size_t)b * 4096 + (size_t)(tt - 1) * 256) * 1024; out = out_l + ((size_t)b * 4096 + (size_t)(tt - 1) * 256) * 1024; gate = gate_l + (size_t)b * 6144; }
        const int col0 = u.pn * BM + wc * 32 + 4 * fq;
#pragma unroll
        for (int ai = 0; ai < 2; ++ai) {
            f32x4 bs[4][2][2];
#pragma unroll
            for (int m = 0; m < 4; ++m) { const size_t off = (size_t)(ai * HALF + wr * 64 + m * 16 + fr) * 1024 + col0;
#pragma unroll
                for (int bj = 0; bj < 2; ++bj)
#pragma unroll
                    for (int n = 0; n < 2; ++n) bs[m][bj][n] = *(const f32x4*)(base + off + bj * HALF + n * 16); }
#pragma unroll
            for (int bj = 0; bj < 2; ++bj)
#pragma unroll
                for (int n = 0; n < 2; ++n) { const f32x4 gvv = *(const f32x4*)(gate + col0 + bj * HALF + n * 16);
#pragma unroll
                    for (int m = 0; m < 4; ++m) { const size_t off = (size_t)(ai * HALF + wr * 64 + m * 16 + fr) * 1024 + col0;
                        *(f32x4*)(out + off + bj * HALF + n * 16) = bs[m][bj][n] + gvv * acc[ai][bj][m][n]; } }
            asm volatile("" ::: "memory");
        }
    }
};
struct EpiUp {
    static constexpr bool PERM = true, AFTER_DRAIN = false;
    bf16_t* O; const float* cw; const float* cb; int MT;
    static __device__ __forceinline__ float ror1(float x) { return __int_as_float(__builtin_amdgcn_update_dpp(0, __float_as_int(x), 0x121, 0xf, 0xf, false)); }
    static __device__ __forceinline__ float ror15(float x) { return __int_as_float(__builtin_amdgcn_update_dpp(0, __float_as_int(x), 0x12F, 0xf, 0xf, false)); }
    static __device__ __forceinline__ float shr1w(float x, float w) { return __int_as_float(__builtin_amdgcn_update_dpp(__float_as_int(w), __float_as_int(x), 0x111, 0xf, 0xf, false)); }
    static __device__ __forceinline__ float shl1w(float x, float w) { return __int_as_float(__builtin_amdgcn_update_dpp(__float_as_int(w), __float_as_int(x), 0x101, 0xf, 0xf, false)); }
    __device__ __forceinline__ void operator()(const f32x4 (&acc)[2][2][4][2], const Unit& u, int wr, int wc, int fr, int fq) const {
        const int cc = u.pn * 128 + wc * 32 + 8 * fq;
        f32x4 cw0[2], cw1[2], cw2[2], cbb[2];
#pragma unroll
        for (int n = 0; n < 2; ++n) { cw0[n] = *(const f32x4*)(cw + cc + 4 * n); cw1[n] = *(const f32x4*)(cw + 2816 + cc + 4 * n); cw2[n] = *(const f32x4*)(cw + 2 * 2816 + cc + 4 * n); cbb[n] = *(const f32x4*)(cb + cc + 4 * n); }
#pragma unroll
        for (int ai = 0; ai < 2; ++ai) {
            const int tok0 = u.pm * 248 + 62 * (2 * ai + wr) - 1;
#pragma unroll
            for (int m = 0; m < 4; ++m) {
                const int j = 16 * m + fr; const int tok = tok0 + j; const int s = tok % 4352;
                const bool pz = (s == 0 || s == 256), nz = (s == 255 || s == 4351);
                const bool edge = __any(pz || nz);
                unsigned pk[4];
#pragma unroll
                for (int n = 0; n < 2; ++n) {
                    const f32x4 w0 = cw0[n], w1 = cw1[n], w2 = cw2[n], bb = cbb[n];
                    const f32x4 g = acc[ai][1][m][n];
                    float r[4];
#pragma unroll
                    for (int e = 0; e < 4; ++e) {
                        const float ge = g[e];
                        float wp = 0.f, wn = 0.f;
                        if (m > 0) { const float gq = acc[ai][1][m > 0 ? m - 1 : 0][n][e]; wp = ror1(gq); }
                        if (m < 3) { const float gq = acc[ai][1][m < 3 ? m + 1 : 3][n][e]; wn = ror15(gq); }
                        float gp = shr1w(ge, wp), gn = shl1w(ge, wn);
                        if (edge) { gp = pz ? 0.f : gp; gn = nz ? 0.f : gn; }
                        const float gc = w0[e] * gp + w1[e] * ge + w2[e] * gn + bb[e];
                        r[e] = gc * __builtin_amdgcn_rcpf(1.f + __expf(-gc)) * acc[ai][0][m][n][e];
                    }
                    pk[2 * n] = cvt_pk_bf16(r[0], r[1]); pk[2 * n + 1] = cvt_pk_bf16(r[2], r[3]);
                }
                if (j >= 1 && j <= 62 && tok < MT) { u32x4 w; w.x = pk[0]; w.y = pk[1]; w.z = pk[2]; w.w = pk[3]; *(u32x4*)(O + (size_t)tok * 2816 + cc) = w; }
                asm volatile("" ::: "memory"); __builtin_amdgcn_sched_barrier(0);
            }
        }
    }
};
template <class Epi, class Sched, bool ALIGN_EPI = false, bool SP2 = false>
__device__ __forceinline__ void gemm_phase(PG8_LAS unsigned char* lds, const Gemm g, const Sched& S, const Epi& E) {
    const int tid = ::otid(), wid = __builtin_amdgcn_readfirstlane(tid >> 6), lane = tid & 63, wr = wid >> 2, wc = wid & 3, fr = lane & 15, fq = lane >> 4;
    const int K = g.K, nt = K / BK;
    unsigned voffA[2], voffB[2];
#pragma unroll
    for (int i = 0; i < 2; ++i) { int R, C; stage_rc(tid * 16 + i * 8192, R, C); const int Rb = Epi::PERM ? ((R & ~31) + perm32(R & 31)) : R;
        voffA[i] = (unsigned)((R - g.a_skip * (R >> 6)) * K + C) * 2u; voffB[i] = (unsigned)(Rb * K + C) * 2u; }
    const size_t kstep = (size_t)(BK * 2);
    const size_t hstep = (size_t)HALF * K * 2;
    const size_t tstep = 2 * hstep; const size_t hstepA = (size_t)(HALF - 2 * g.a_skip) * K * 2, tstepA = 2 * hstepA;
    const unsigned ldsw = (unsigned)wid * 1024u;
    const int aoff = lds_byte(wr * 64 + fr, fq * 8), boff = lds_byte(wc * 32 + fr, fq * 8);
#define PG8_SA(b, h) (((b) * 2 + (h)) * HTB)
#define PG8_SB(b, h) ((4 + (b) * 2 + (h)) * HTB)
#define PG8_STAGE(bufoff, gbase, voff) do { _Pragma("unroll") for (int _i = 0; _i < 2; ++_i) \
        __builtin_amdgcn_global_load_lds((const unsigned*)((const char*)(gbase) + (voff)[_i]), (PG8_LAS unsigned*)(lds + (bufoff) + ldsw + _i * 8192), 16, 0, 0); } while (0)
#define PG8_LDA(dst, b, h) do { _Pragma("unroll") for (int m = 0; m < 4; ++m) _Pragma("unroll") for (int k = 0; k < 2; ++k) dst[m][k] = *(const PG8_LAS bf16x8*)(lds + PG8_SA(b, h) + aoff + m * 2048 + k * 1024); } while (0)
#define PG8_LDB(dst, b, h) do { _Pragma("unroll") for (int n = 0; n < 2; ++n) _Pragma("unroll") for (int k = 0; k < 2; ++k) dst[n][k] = *(const PG8_LAS bf16x8*)(lds + PG8_SB(b, h) + boff + n * 2048 + k * 1024); } while (0)
#define PG8_MMA(ai, bj, At, Bt) do { __builtin_amdgcn_s_setprio(1); _Pragma("unroll") for (int m = 0; m < 4; ++m) _Pragma("unroll") for (int n = 0; n < 2; ++n) _Pragma("unroll") for (int k = 0; k < 2; ++k) \
        acc[ai][bj][m][n] = __builtin_amdgcn_mfma_f32_16x16x32_bf16(Bt[n][k], At[m][k], acc[ai][bj][m][n], 0, 0, 0); __builtin_amdgcn_s_setprio(0); } while (0)
#define PG8_WAIT_V(n) asm volatile("s_waitcnt vmcnt(" #n ")" ::: "memory")
#define PG8_WAIT_L(n) asm volatile("s_waitcnt lgkmcnt(" #n ")" ::: "memory")
#define PG8_BAR __builtin_amdgcn_s_barrier()
#define PG8_SCHED __builtin_amdgcn_sched_barrier(0)
    Unit cur, nxt; int ui = 0;
    if (!S.next(0, cur)) return;
    f32x4 acc[2][2][4][2];
#pragma unroll
    for (int a = 0; a < 2; ++a)
#pragma unroll
        for (int b = 0; b < 2; ++b)
#pragma unroll
            for (int m = 0; m < 4; ++m)
#pragma unroll
                for (int n = 0; n < 2; ++n) acc[a][b][m][n] = (f32x4){0.f, 0.f, 0.f, 0.f};
    bf16x8 At[4][2], B0[2][2], B1[2][2];
    const char* cA = (const char*)g.A + (size_t)cur.pm * tstepA; const char* cB = (const char*)g.Bt + (size_t)cur.pn * tstep;
    S.a_ready(cur);
    if constexpr (SP2) {
        PG8_STAGE(PG8_SB(0, 0), cB, voffB); PG8_STAGE(PG8_SB(0, 1), cB + hstep, voffB); PG8_STAGE(PG8_SA(0, 0), cA, voffA); PG8_STAGE(PG8_SA(0, 1), cA + hstepA, voffA);
        if (wr == 1) PG8_BAR;
        PG8_WAIT_V(2); PG8_BAR;
        PG8_STAGE(PG8_SB(1, 0), cB + kstep, voffB); PG8_STAGE(PG8_SA(1, 0), cA + kstep, voffA); PG8_STAGE(PG8_SB(1, 1), cB + hstep + kstep, voffB);
        PG8_WAIT_V(6); PG8_BAR;
    } else {
        PG8_STAGE(PG8_SB(0, 0), cB, voffB); PG8_STAGE(PG8_SA(0, 0), cA, voffA); PG8_STAGE(PG8_SB(0, 1), cB + hstep, voffB); PG8_STAGE(PG8_SA(0, 1), cA + hstepA, voffA);
        if (wr == 1) PG8_BAR;
        PG8_WAIT_V(4); PG8_BAR;
        PG8_STAGE(PG8_SB(1, 0), cB + kstep, voffB); PG8_STAGE(PG8_SA(1, 0), cA + kstep, voffA); PG8_STAGE(PG8_SB(1, 1), cB + hstep + kstep, voffB);
        PG8_WAIT_V(6); PG8_BAR;
    }
    for (;;) {
        const bool has_next = S.next(ui + 1, nxt);
        const char* nA = has_next ? (const char*)g.A + (size_t)nxt.pm * tstepA : cA; const char* nB = has_next ? (const char*)g.Bt + (size_t)nxt.pn * tstep : cB;
        for (int t = 0; t < nt; t += 2) {
            const bool last = (t == nt - 2);
            const char* a1 = cA + (size_t)(t + 1) * kstep;
            const char* a2 = last ? nA : cA + (size_t)(t + 2) * kstep; const char* b2 = last ? nB : cB + (size_t)(t + 2) * kstep;
            const char* a3 = a2 + kstep; const char* b3 = b2 + kstep;
            if (last && has_next) S.a_ready(nxt);
            if constexpr (SP2) {
            PG8_LDB(B0, 0, 0); PG8_LDB(B1, 0, 1); PG8_SCHED; PG8_LDA(At, 0, 0); PG8_STAGE(PG8_SA(1, 1), a1 + hstepA, voffA);
            PG8_WAIT_V(8); PG8_WAIT_L(0); PG8_BAR; PG8_MMA(0, 0, At, B0); PG8_MMA(0, 1, At, B1); PG8_BAR; PG8_SCHED;
            PG8_LDA(At, 0, 1); PG8_STAGE(PG8_SB(0, 0), b2, voffB); PG8_STAGE(PG8_SB(0, 1), b2 + hstep, voffB); PG8_STAGE(PG8_SA(0, 0), a2, voffA);
            PG8_WAIT_V(8); PG8_WAIT_L(0); PG8_BAR; PG8_MMA(1, 0, At, B0); PG8_MMA(1, 1, At, B1); PG8_BAR; PG8_SCHED;
            PG8_LDB(B0, 1, 0); PG8_LDB(B1, 1, 1); PG8_SCHED; PG8_LDA(At, 1, 0); PG8_STAGE(PG8_SA(0, 1), a2 + hstepA, voffA);
            PG8_WAIT_V(8); PG8_WAIT_L(0); PG8_BAR; PG8_MMA(0, 0, At, B0); PG8_MMA(0, 1, At, B1); PG8_BAR; PG8_SCHED;
            PG8_LDA(At, 1, 1); PG8_STAGE(PG8_SB(1, 0), b3, voffB); PG8_STAGE(PG8_SB(1, 1), b3 + hstep, voffB); PG8_STAGE(PG8_SA(1, 0), a3, voffA);
            PG8_WAIT_V(8); PG8_WAIT_L(0); PG8_BAR; PG8_MMA(1, 0, At, B0); PG8_MMA(1, 1, At, B1); PG8_BAR; PG8_SCHED;
            } else {
            PG8_LDB(B0, 0, 0); PG8_SCHED; PG8_LDA(At, 0, 0); PG8_STAGE(PG8_SA(1, 1), a1 + hstepA, voffA);
            PG8_WAIT_L(8); PG8_BAR; PG8_WAIT_L(0); PG8_MMA(0, 0, At, B0); PG8_BAR; PG8_SCHED;
            PG8_LDB(B1, 0, 1); PG8_STAGE(PG8_SB(0, 0), b2, voffB);
            PG8_BAR; PG8_WAIT_L(0); PG8_MMA(0, 1, At, B1); PG8_BAR;
            PG8_LDA(At, 0, 1); PG8_STAGE(PG8_SA(0, 0), a2, voffA);
            PG8_BAR; PG8_WAIT_L(0); PG8_MMA(1, 0, At, B0); PG8_BAR; PG8_SCHED;
            PG8_STAGE(PG8_SB(0, 1), b2 + hstep, voffB);
            PG8_WAIT_V(6); PG8_BAR; PG8_MMA(1, 1, At, B1); PG8_BAR;
            PG8_LDB(B0, 1, 0); PG8_SCHED; PG8_LDA(At, 1, 0); PG8_STAGE(PG8_SA(0, 1), a2 + hstepA, voffA);
            PG8_WAIT_L(8); PG8_BAR; PG8_WAIT_L(0); PG8_MMA(0, 0, At, B0); PG8_BAR; PG8_SCHED;
            PG8_LDB(B1, 1, 1); PG8_STAGE(PG8_SB(1, 0), b3, voffB);
            PG8_BAR; PG8_WAIT_L(0); PG8_MMA(0, 1, At, B1); PG8_BAR;
            PG8_LDA(At, 1, 1); PG8_STAGE(PG8_SA(1, 0), a3, voffA);
            PG8_BAR; PG8_WAIT_L(0); PG8_MMA(1, 0, At, B0); PG8_BAR; PG8_SCHED;
            PG8_STAGE(PG8_SB(1, 1), b3 + hstep, voffB);
            PG8_WAIT_V(6); PG8_BAR; PG8_MMA(1, 1, At, B1); PG8_BAR;
            }
        }
        if constexpr (ALIGN_EPI) { if (wr == 0) PG8_BAR; }
        if constexpr (!Epi::AFTER_DRAIN) { E(acc, cur, wr, wc, fr, fq); S.done(cur); }
        if (!has_next) break;
#pragma unroll
        for (int a = 0; a < 2; ++a)
#pragma unroll
            for (int b = 0; b < 2; ++b)
#pragma unroll
                for (int m = 0; m < 4; ++m)
#pragma unroll
                    for (int n = 0; n < 2; ++n) acc[a][b][m][n] = (f32x4){0.f, 0.f, 0.f, 0.f};
        cur = nxt; cA = nA; cB = nB; ++ui;
        if constexpr (ALIGN_EPI) { if (wr == 1) PG8_BAR; }
    }
    PG8_WAIT_V(0);
    if constexpr (!ALIGN_EPI) { if (wr == 0) PG8_BAR; }
    PG8_BAR;
    if constexpr (Epi::AFTER_DRAIN) { E.fused(acc, cur, wr, wc, fr, fq, lds, wid, lane); S.done(cur); }
#undef PG8_SA
#undef PG8_SB
#undef PG8_STAGE
#undef PG8_LDA
#undef PG8_LDB
#undef PG8_MMA
#undef PG8_WAIT_V
#undef PG8_WAIT_L
#undef PG8_BAR
#undef PG8_SCHED
}
}
typedef unsigned short bf16;
typedef unsigned v4u __attribute__((ext_vector_type(4)));
typedef unsigned v2u __attribute__((ext_vector_type(2)));
typedef float f32x4 __attribute__((ext_vector_type(4)));
typedef float f32x16 __attribute__((ext_vector_type(16)));
typedef short bf16x8 __attribute__((ext_vector_type(8)));
constexpr int DM = 1024, NB = 16, SEQ = 4096, CTX = 256, SB = SEQ + CTX, MT = NB * SB, DEPTH = 4;
constexpr int INC = 1472, INP = 1536, DFF = 2816;
constexpr float EPS = 1e-6f;
constexpr int ZC_CKV = 0, ZC_KR = 128, ZC_GK = 160, ZC_GV = 288, ZC_LR = 544, ZC_POOL = 576, ZC_CQ = 832, ZC_GQ = 1088, ZC_OG = 1216;
constexpr int NTHREADS = 512, NWAVES = 8;
constexpr int LDS_BYTES = 147456;
constexpr size_t al256(size_t x) { return (x + 255) & ~(size_t)255; }
constexpr size_t WS_XC = 0;
constexpr size_t WS_ADAL = WS_XC + (size_t)NB * CTX * DM * 4;
constexpr size_t WS_ADAC = WS_ADAL + (size_t)DEPTH * NB * 6144 * 4;
constexpr size_t WS_ROPE = WS_ADAC + (size_t)DEPTH * 6144 * 4;
constexpr size_t WS_W = WS_ROPE + (size_t)SEQ * 16 * 2 * 4;
constexpr size_t WO_IN = 0, WO_KN = WO_IN + (size_t)INP * DM, WO_V = WO_KN + 512 * 256, WO_UQ = WO_V + 512 * 256, WO_O = WO_UQ + 768 * 256,
                 WO_UP = WO_O + (size_t)DM * DM, WO_DN = WO_UP + (size_t)2 * DFF * DM, W_LAYER_ELEMS = WO_DN + (size_t)DM * DFF;
constexpr size_t WS_H = al256(WS_W + W_LAYER_ELEMS * 2 * DEPTH);
constexpr size_t WS_Z = al256(WS_H + (size_t)(MT + 512) * DM * 2);
constexpr size_t WS_K = al256(WS_Z + (size_t)MT * INP * 2);
constexpr size_t WS_Q = al256(WS_K + (size_t)MT * 768 * 2);
constexpr size_t WS_AFF = WS_Z;
constexpr size_t WS_VT = al256(WS_Q + (size_t)MT * 768 * 2);
constexpr size_t WS_AKV = al256(WS_VT + (size_t)512 * MT * 2);
constexpr size_t WS_AQ = al256(WS_AKV + (size_t)MT * 256 * 2);
constexpr size_t WS_GKV = al256(WS_AQ + (size_t)MT * 256 * 2);
constexpr size_t WS_GDC = al256(WS_GKV + (size_t)128 * 68 * 2048 * 4);
constexpr size_t WS_DIAG = al256(WS_GDC + (size_t)128 * 68 * 32 * 4);
constexpr size_t WS_BAR = WS_DIAG + 256;
constexpr size_t WS_DIAG2 = WS_BAR + 16384;
constexpr size_t WS_END = WS_DIAG2 + 4096;
static_assert(WS_AFF + (size_t)MT * DFF * 2 <= WS_VT, "A_ff overlay");
static_assert(WS_END <= (size_t)1 << 30, "workspace");

struct Params {
    const float *x, *c, *ctx, *c_ctx, *w_ada, *b_ada, *norm1, *norm2, *w_in, *q_norm, *w_uq, *kv_norm, *w_ukv, *w_gk_f, *b_gk_f, *w_gk_b, *b_gk_b,
                *gla_norm, *w_pool, *pool_scale, *w_o, *w_up, *conv_w, *conv_b, *w_down, *norm_f;
    float* out; unsigned char* ws;
};

typedef const __attribute__((address_space(4))) Params* PP;
#define LDS_WAIT() asm volatile("s_waitcnt lgkmcnt(0)" ::: "memory")
__device__ __forceinline__ float bf2f(unsigned short h) { return __builtin_bit_cast(float, (unsigned)h << 16); }
__device__ __forceinline__ float bflo(unsigned w) { return __builtin_bit_cast(float, w << 16); }
__device__ __forceinline__ float bfhi(unsigned w) { return __builtin_bit_cast(float, w & 0xffff0000u); }
__device__ __forceinline__ unsigned pk2(float lo, float hi) { return pg8::cvt_pk_bf16(lo, hi); }
__device__ __forceinline__ float wave_sum(float v, int lane) {
#pragma unroll
    for (int o = 1; o < 64; o <<= 1) v += shx(v, o, lane);
    return v;
}
__device__ __forceinline__ float silu_f(float x) { return x / (1.f + __expf(-x)); }
__device__ __forceinline__ float logsig_f(float x) { return fminf(x, 0.f) - log1pf(__expf(-fabsf(x))); }

__device__ __forceinline__ const float* xin_row(PP p, int layer, int m) {
    const int b = m / SB, s = m % SB;
    if (s < CTX) return (layer == 0 ? p->ctx : (const float*)(p->ws + WS_XC)) + ((size_t)b * CTX + s) * DM;
    return (layer == 0 ? p->x : (const float*)p->out) + ((size_t)b * SEQ + (s - CTX)) * DM;
}
__device__ __forceinline__ const float* xcur_row(PP p, int m) {
    const int b = m / SB, s = m % SB;
    if (s < CTX) return (const float*)(p->ws + WS_XC) + ((size_t)b * CTX + s) * DM;
    return (const float*)p->out + ((size_t)b * SEQ + (s - CTX)) * DM;
}

__device__ __forceinline__ void tr_write(const float* scr, bf16* WT, size_t ldk, int row0, int k0, int lane) {
    const int c = lane & 7;
#pragma unroll
    for (int j = 0; j < 4; ++j) { const int n = (lane >> 3) + 8 * j; const float* s = scr + (8 * c) * 33 + n;
        v4u o; o.x = pk2(s[0 * 33], s[1 * 33]); o.y = pk2(s[2 * 33], s[3 * 33]); o.z = pk2(s[4 * 33], s[5 * 33]); o.w = pk2(s[6 * 33], s[7 * 33]);
        *(v4u*)(WT + (size_t)(row0 + n) * ldk + k0 + 8 * c) = o; }
    LDS_WAIT(); __builtin_amdgcn_wave_barrier();
}
__device__ __forceinline__ void tr_item(const float* W, int ldn, int src_n0, int k0, bf16* WT, size_t ldk, int row0, float* scr, int lane) {
#pragma unroll 8
    for (int i = 0; i < 32; ++i) { const int kk = 2 * i + (lane >> 5); scr[kk * 33 + (lane & 31)] = W[(size_t)(k0 + kk) * ldn + src_n0 + (lane & 31)]; }
    LDS_WAIT(); __builtin_amdgcn_wave_barrier();
    tr_write(scr, WT, ldk, row0, k0, lane);
}
__device__ __forceinline__ void phase_s0(PP p, unsigned char* lds) {
    const int tid = otid(), lane = tid & 63, wave = tid >> 6;
    {
        float* scr = (float*)(lds + wave * 16384);
        const int gw = obid() * NWAVES + wave, NGW = gridDim.x * NWAVES;
        constexpr int I_IN = 16 * 46, I_INZ = 64, I_UQ = 4 * 24, I_KN = 32, I_V = 32, I_PADZ = 64, I_O = 12 * 32, I_OF = 128, I_UP = 16 * 176, I_DN = 44 * 32;
        constexpr int PER_LAYER = I_IN + I_INZ + I_UQ + I_KN + I_V + I_PADZ + I_O + I_OF + I_UP + I_DN;
        for (int it = gw; it < PER_LAYER * DEPTH; it += NGW) {
            const int L = it / PER_LAYER; int r = it % PER_LAYER;
            bf16* WL = (bf16*)(p->ws + WS_W) + (size_t)L * W_LAYER_ELEMS;
            if (r < I_IN) { const int kb = r / 46, nb = r % 46; tr_item(p->w_in + (size_t)L * DM * INC, INC, nb * 32, kb * 64, WL + WO_IN, DM, nb * 32, scr, lane); continue; } r -= I_IN;
            if (r < I_INZ) { v4u z = {0u, 0u, 0u, 0u}; bf16* row = WL + WO_IN + (size_t)(INC + r) * DM; *(v4u*)(row + lane * 16) = z; *(v4u*)(row + lane * 16 + 8) = z; continue; } r -= I_INZ;
            if (r < I_UQ) { const int kb = r / 24, nb = r % 24; tr_item(p->w_uq + (size_t)L * 256 * 768, 768, nb * 32, kb * 64, WL + WO_UQ, 256, nb * 32, scr, lane); continue; } r -= I_UQ;
            if (r < I_KN) { const int kb = r / 16, nb = r % 16; tr_item(p->w_ukv + (size_t)L * 128 * 1024, 1024, (nb >> 1) * 128 + (nb & 1) * 32, kb * 64, WL + WO_KN, 256, nb * 32, scr, lane); continue; } r -= I_KN;
            if (r < I_V) { const int kb = r / 16, nb = r % 16; tr_item(p->w_ukv + (size_t)L * 128 * 1024, 1024, (nb >> 1) * 128 + 64 + (nb & 1) * 32, kb * 64, WL + WO_V, 256, nb * 32, scr, lane); continue; } r -= I_V;
            if (r < I_PADZ) {
                const int row = r * 16 + (lane >> 2); bf16* dst = WL + WO_KN + (size_t)row * 256 + 128 + (lane & 3) * 32; v4u z = {0u, 0u, 0u, 0u};
                *(v4u*)(dst) = z; *(v4u*)(dst + 8) = z; *(v4u*)(dst + 16) = z; *(v4u*)(dst + 24) = z; continue; } r -= I_PADZ;
            if (r < I_O) { const int kb = 4 + r / 32, nb = r % 32; tr_item(p->w_o + (size_t)L * DM * DM, DM, nb * 32, kb * 64, WL + WO_O, DM, nb * 32, scr, lane); continue; } r -= I_O;
            if (r < I_OF) {
                const int g = r / 32, nb = r % 32, n = lane & 31, ch = lane >> 5;
                const float* wo = p->w_o + (size_t)L * DM * DM + (size_t)(g * 64) * DM + nb * 32 + n;
                const float* ps = p->pool_scale + L * 256 + g * 64;
                const float* wp = p->w_pool + (size_t)L * 4 * 64 * 64 + (size_t)g * 64 * 64;
                for (int ci = 0; ci < 32; ++ci) { const int c = ch * 32 + ci; float a = 0.f;
                    for (int d = 0; d < 64; ++d) a += wp[c * 64 + d] * ps[d] * wo[(size_t)d * DM];
                    scr[c * 33 + n] = a; }
                LDS_WAIT(); __builtin_amdgcn_wave_barrier();
                tr_write(scr, WL + WO_O, DM, nb * 32, g * 64, lane); continue; } r -= I_OF;
            if (r < I_UP) { const int kb = r / 176, nb = r % 176, pn = nb >> 3, q = nb & 7; const int src = (q < 4) ? (128 * pn + 32 * q) : (DFF + 128 * pn + 32 * (q - 4));
                tr_item(p->w_up + (size_t)L * DM * 2 * DFF, 2 * DFF, src, kb * 64, WL + WO_UP, DM, nb * 32, scr, lane); continue; } r -= I_UP;
            { const int kb = r / 32, nb = r % 32; tr_item(p->w_down + (size_t)L * DFF * DM, DM, nb * 32, kb * 64, WL + WO_DN, DFF, nb * 32, scr, lane); }
        }
    }
    __syncthreads();
    {
        float* rope = (float*)(p->ws + WS_ROPE);
        for (int i = obid() * NTHREADS + tid; i < SEQ * 16; i += gridDim.x * NTHREADS) {
            const int pos = i >> 4, e = i & 15, axis = e >> 3, f = e & 7;
            const float inv = powf(10000.0f, -(float)f / 8.0f);
            const float ang = (float)(axis == 0 ? (pos >> 6) : (pos & 63)) * inv;
            float sn, cs; sincosf(ang, &sn, &cs);
            rope[2 * i] = cs; rope[2 * i + 1] = sn;
        }
    }
    {
        float* sc = (float*)lds;
        float* red = (float*)(lds + 17 * 1024 * 4);
        bool loaded = false;
        for (int it = obid(); it < DEPTH * 96; it += gridDim.x) {
            if (!loaded) { for (int i = tid; i < 17 * 1024; i += NTHREADS) { const float v = (i < 16 * 1024) ? p->c[i] : p->c_ctx[i - 16 * 1024]; sc[i] = silu_f(v); } loaded = true; }
            __syncthreads();
            const int L = it / 96, cb = it % 96, col = tid & 63, kg = tid >> 6;
            float acc[17];
#pragma unroll
            for (int r = 0; r < 17; ++r) acc[r] = 0.f;
            const float* w = p->w_ada + ((size_t)L * DM + kg * 128) * 6144 + cb * 64 + col;
            for (int k = 0; k < 128; ++k) { const float wv = w[(size_t)k * 6144];
#pragma unroll
                for (int r = 0; r < 17; ++r) acc[r] += sc[r * 1024 + kg * 128 + k] * wv; }
#pragma unroll
            for (int r = 0; r < 17; ++r) red[(kg * 17 + r) * 64 + col] = acc[r];
            __syncthreads();
            for (int o = tid; o < 17 * 64; o += NTHREADS) { const int r = o >> 6, cl = o & 63; float s = p->b_ada[L * 6144 + cb * 64 + cl];
#pragma unroll
                for (int g = 0; g < 8; ++g) s += red[(g * 17 + r) * 64 + cl];
                if (r < 16) ((float*)(p->ws + WS_ADAL))[((size_t)L * NB + r) * 6144 + cb * 64 + cl] = s;
                else ((float*)(p->ws + WS_ADAC))[(size_t)L * 6144 + cb * 64 + cl] = s; }
            __syncthreads();
        }
    }
}

__device__ __forceinline__ void phase_norm(PP p, int layer, int which) {
    const int tid_ = otid(); const int lane = tid_ & 63, wave = tid_ >> 6;
    const int gw = obid() * NWAVES + wave, NGW = gridDim.x * NWAVES;
    bf16* H = (bf16*)(p->ws + WS_H) + (size_t)256 * DM;
    const float* gn = (which ? p->norm2 : p->norm1) + layer * DM;
    f32x4 g4[4];
#pragma unroll
    for (int j = 0; j < 4; ++j) g4[j] = *(const f32x4*)(gn + 4 * lane + 256 * j);
    for (int m0 = gw; m0 < MT; m0 += 2 * NGW) {
        int mm[2]; mm[0] = m0; mm[1] = (m0 + NGW < MT) ? m0 + NGW : m0;
        f32x4 v[2][4], sh[2][4], sc[2][4]; float ss[2];
#pragma unroll
        for (int u = 0; u < 2; ++u) { const int m = mm[u]; const int b = m / SB, s = m % SB;
            const float* xr = which ? xcur_row(p, m) : xin_row(p, layer, m);
            const float* mod = (s < CTX) ? (const float*)(p->ws + WS_ADAC) + (size_t)layer * 6144 : (const float*)(p->ws + WS_ADAL) + ((size_t)layer * NB + b) * 6144;
            const float* shift = mod + (which ? 3 : 0) * DM; const float* scale = mod + (which ? 4 : 1) * DM;
#pragma unroll
            for (int j = 0; j < 4; ++j) { v[u][j] = __builtin_nontemporal_load((const f32x4*)(xr + 4 * lane + 256 * j)); sh[u][j] = *(const f32x4*)(shift + 4 * lane + 256 * j); sc[u][j] = *(const f32x4*)(scale + 4 * lane + 256 * j); } }
#pragma unroll
        for (int u = 0; u < 2; ++u) { float a = 0.f;
#pragma unroll
            for (int j = 0; j < 4; ++j) a += (v[u][j].x * v[u][j].x + v[u][j].y * v[u][j].y) + (v[u][j].z * v[u][j].z + v[u][j].w * v[u][j].w);
            ss[u] = a; }
#pragma unroll
        for (int o = 1; o < 64; o <<= 1) { ss[0] += shx(ss[0], o, lane); ss[1] += shx(ss[1], o, lane); }
#pragma unroll
        for (int u = 0; u < 2; ++u) {
            if (u == 1 && mm[1] == m0) break;
            const int m = mm[u]; const int s = m % SB;
            if (which && layer == DEPTH - 1 && s < CTX) continue;
            const float rstd = rsqrtf(ss[u] * (1.f / DM) + EPS);
#pragma unroll
            for (int j = 0; j < 4; ++j) { const int c = 4 * lane + 256 * j;
                const f32x4 h = (v[u][j] * rstd) * g4[j] * (sc[u][j] + 1.0f) + sh[u][j];
                v2u o; o.x = pk2(h.x, h.y); o.y = pk2(h.z, h.w); *(v2u*)(H + (size_t)m * DM + c) = o; }
        }
    }
}

constexpr int GL_Q = 0, GL_K = 2112, GL_BF = 4224, GL_BB = 6336, GL_OP = 0  , GL_LR = 8448, GL_V = 10496,
              GL_QE = 14592  , GL_KE = 18816  , GL_ATT = 23040  , GL_S = 31360  ;
static_assert((GL_S + 4096) * 4 <= LDS_BYTES, "GLA LDS map");
__device__ __forceinline__ f32x16 mfma_f32(float a, float b, f32x16 c) { return __builtin_amdgcn_mfma_f32_32x32x2f32(a, b, c, 0, 0, 0); }
constexpr int GL_W = 35456;
static_assert((GL_W + 1024) * 4 <= LDS_BYTES - 64, "GLA LDS map (weights)");
__device__ __forceinline__ float logsig_fast(float x) { return fminf(x, 0.f) - __logf(1.f + __expf(-fabsf(x))); }
struct GlaRegs { v2u q, k, l; v4u v, og; f32x4 s0, s1; };
__device__ __forceinline__ void gla_prefetch(PP p, GlaRegs& R, int it, bool with_q, int tid) {
    const int h = it & 3, c = (it >> 2) % 68, b = it / (68 * 4); const int m0 = b * SB + c * 64;
    const bf16* Z = (const bf16*)(p->ws + WS_Z); const int j = tid >> 3, e = tid & 7; const bf16* zr = Z + (size_t)(m0 + j) * INP;
    R.k = *(const v2u*)(zr + ZC_GK + h * 32 + e * 4); R.v = *(const v4u*)(zr + ZC_GV + h * 64 + e * 8); R.l = *(const v2u*)(zr + ZC_LR + e * 4);
    if (with_q) {
        R.q = *(const v2u*)(zr + ZC_GQ + h * 32 + e * 4); R.og = *(const v4u*)(zr + ZC_OG + h * 64 + e * 8);
        const float* KV = (const float*)(p->ws + WS_GKV);
        const int pb = (c < 4 ? 3 - c : 71 - c);
        R.s0 = *(const f32x4*)(KV + ((size_t)((b * 4 + h) * 2 + 0) * 68 + c) * 2048 + tid * 4);
        R.s1 = *(const f32x4*)(KV + ((size_t)((b * 4 + h) * 2 + 1) * 68 + pb) * 2048 + tid * 4);
    }
}
__device__ __forceinline__ void gla_stage(PP p, int layer, float* L, const GlaRegs& R, int h, int& h_ld, bool with_q, int tid) {
    const int lane = tid & 63, wave = tid >> 6; const int j = tid >> 3, e = tid & 7;
    if (h != h_ld) {
        for (int i = tid; i < 1024; i += NTHREADS) { const int dir = i >> 9, r = (i >> 5) & 15, d = i & 31; L[GL_W + i] = (dir ? p->w_gk_b : p->w_gk_f)[(size_t)layer * 16 * 128 + r * 128 + h * 32 + d]; }
        h_ld = h;
    }
    { float* d = L + GL_K + j * 33 + e * 4; d[0] = bflo(R.k.x); d[1] = bfhi(R.k.x); d[2] = bflo(R.k.y); d[3] = bfhi(R.k.y); }
    { float* d = L + GL_V + j * 64 + e * 8; d[0] = bflo(R.v.x); d[1] = bfhi(R.v.x); d[2] = bflo(R.v.y); d[3] = bfhi(R.v.y); d[4] = bflo(R.v.z); d[5] = bfhi(R.v.z); d[6] = bflo(R.v.w); d[7] = bfhi(R.v.w); }
    { float* d = L + GL_LR + j * 32 + e * 4; d[0] = bflo(R.l.x); d[1] = bfhi(R.l.x); d[2] = bflo(R.l.y); d[3] = bfhi(R.l.y); }
    if (with_q) { float* d = L + GL_Q + j * 33 + e * 4; d[0] = bflo(R.q.x); d[1] = bfhi(R.q.x); d[2] = bflo(R.q.y); d[3] = bfhi(R.q.y); }
    __syncthreads();
    {
        f32x4 af = *(const f32x4*)(p->b_gk_f + layer * 128 + h * 32 + e * 4), ab = *(const f32x4*)(p->b_gk_b + layer * 128 + h * 32 + e * 4);
#pragma unroll
        for (int r = 0; r < 16; ++r) { const float lf = L[GL_LR + j * 32 + r], lb = L[GL_LR + j * 32 + 16 + r];
            af += *(const f32x4*)(L + GL_W + r * 32 + e * 4) * lf; ab += *(const f32x4*)(L + GL_W + 512 + r * 32 + e * 4) * lb; }
#pragma unroll
        for (int d = 0; d < 4; ++d) { L[GL_BF + j * 33 + e * 4 + d] = logsig_fast(af[d]) * (1.f / 16.f); L[GL_BB + j * 33 + e * 4 + d] = logsig_fast(ab[d]) * (1.f / 16.f); }
    }
    __syncthreads();
    {
#pragma unroll 2
        for (int cc = 0; cc < 8; ++cc) { const int c = wave * 8 + cc, dir = c >> 5, d = c & 31; const int jj = dir ? 63 - lane : lane;
            float* bp = L + (dir ? GL_BB : GL_BF) + jj * 33 + d; float v = *bp;
#pragma unroll
            for (int o = 1; o < 64; o <<= 1) { const float t = shup(v, o, lane); if (lane >= o) v += t; }
            *bp = v; }
    }
    __syncthreads();
}
__device__ __forceinline__ void phase_gla_kv(PP p, int layer, unsigned char* lds) {
    float* L = (float*)lds; const int tid = otid(); const int lane = tid & 63, wave = tid >> 6, i32 = lane & 31, hi = lane >> 5;
    float* KV = (float*)(p->ws + WS_GKV); float* DC = (float*)(p->ws + WS_GDC);
    const int N = NB * 68 * 4, G = gridDim.x; int h_ld = -1;
    GlaRegs Rn; int it = obid();
    if (it < N) gla_prefetch(p, Rn, it, false, tid);
    for (; it < N; it += G) {
        const int h = it & 3, c = (it >> 2) % 68, b = it / (68 * 4);
        GlaRegs Rc = Rn;
        gla_stage(p, layer, L, Rc, h, h_ld, false, tid);
        if (it + G < N) gla_prefetch(p, Rn, it + G, false, tid);
        {
            const int j = tid >> 3, e = tid & 7;
#pragma unroll
            for (int d4 = 0; d4 < 4; ++d4) { const int d = e * 4 + d4; const float k = L[GL_K + j * 33 + d];
                L[GL_QE + j * 33 + d] = k * __expf(L[GL_BF + 63 * 33 + d] - L[GL_BF + j * 33 + d]);
                L[GL_KE + j * 33 + d] = k * __expf(L[GL_BB + d] - L[GL_BB + j * 33 + d]); }
        }
        __syncthreads();
        if (wave < 4) {
            const int dir = wave >> 1, vh = wave & 1; const float* KE = L + (dir ? GL_KE : GL_QE);
            f32x16 acc;
#pragma unroll
            for (int r = 0; r < 16; ++r) acc[r] = 0.f;
#pragma unroll 8
            for (int kk = 0; kk < 32; ++kk) { const int jx = 2 * kk + hi; acc = mfma_f32(KE[jx * 33 + i32], L[GL_V + jx * 64 + 32 * vh + i32], acc); }
            const int pos = dir ? (c < 4 ? 3 - c : 71 - c) : c; float* dst = KV + ((size_t)((b * 4 + h) * 2 + dir) * 68 + pos) * 2048 + 32 * vh + i32;
#pragma unroll
            for (int r = 0; r < 16; ++r) { const int d = (r & 3) + 8 * (r >> 2) + 4 * hi; dst[d * 64] = acc[r]; }
        } else if (wave == 4) { const int dr = lane >> 5, dd = lane & 31; const int ps = dr ? (c < 4 ? 3 - c : 71 - c) : c;
            DC[((size_t)((b * 4 + h) * 2 + dr) * 68 + ps) * 32 + dd] = __expf(dr ? L[GL_BB + dd] : L[GL_BF + 63 * 33 + dd]); }
        __syncthreads();
    }
}
__device__ __forceinline__ void phase_gla_scan(PP p) {
    float* KV = (float*)(p->ws + WS_GKV); const float* DC = (const float*)(p->ws + WS_GDC);
    const int T = gridDim.x * NTHREADS;
    for (int idx = obid() * NTHREADS + otid(); idx < 128 * 2048; idx += 2 * T) {
        int ix[2]; ix[0] = idx; ix[1] = (idx + T < 128 * 2048) ? idx + T : idx;
        float s[2] = {0.f, 0.f};
#pragma unroll 1
        for (int c2 = 0; c2 < 4; ++c2) {
            float t[2][17], dcy[2][17];
#pragma unroll
            for (int u = 0; u < 2; ++u) { const int chain = ix[u] >> 11, e = ix[u] & 2047, d = e >> 6;
                const float* kv = KV + (size_t)chain * 68 * 2048 + e; const float* dc = DC + (size_t)chain * 68 * 32 + d;
#pragma unroll
                for (int i = 0; i < 17; ++i) { t[u][i] = kv[(size_t)(c2 * 17 + i) * 2048]; dcy[u][i] = dc[(c2 * 17 + i) * 32]; } }
#pragma unroll
            for (int u = 0; u < 2; ++u) { if (u == 1 && ix[1] == idx) break;
                const int chain = ix[u] >> 11, e = ix[u] & 2047; float* kv = KV + (size_t)chain * 68 * 2048 + e;
#pragma unroll
                for (int i = 0; i < 17; ++i) { kv[(size_t)(c2 * 17 + i) * 2048] = s[u]; s[u] = dcy[u][i] * s[u] + t[u][i]; } }
        }
    }
}
__device__ __forceinline__ void phase_gla_out(PP p, int layer, unsigned char* lds) {
    float* L = (float*)lds; const int tid = otid(); const int lane = tid & 63, wave = tid >> 6, i32 = lane & 31, hi = lane >> 5;
    bf16* Y = (bf16*)(p->ws + WS_H) + (size_t)256 * DM;
    const float qs = 0.17677669529663687f;
    const int N = NB * 68 * 4, G = gridDim.x; int h_ld = -1;
    GlaRegs Rn; int it = obid();
    if (it < N) gla_prefetch(p, Rn, it, true, tid);
    for (; it < N; it += G) {
        const int h = it & 3, c = (it >> 2) % 68, b = it / (68 * 4); const int m0 = b * SB + c * 64;
        GlaRegs Rc = Rn;
        gla_stage(p, layer, L, Rc, h, h_ld, true, tid);
        if (it + G < N) gla_prefetch(p, Rn, it + G, true, tid);
        {
            const int i = tid >> 3, e = tid & 7;
#pragma unroll
            for (int dir = 0; dir < 2; ++dir) { const float* B = L + (dir ? GL_BB : GL_BF); const int mid = dir ? 31 : 32;
#pragma unroll
                for (int d4 = 0; d4 < 4; ++d4) { const int d = e * 4 + d4; const float bi = B[i * 33 + d], bm = B[mid * 33 + d];
                    L[GL_QE + dir * 2112 + i * 33 + d] = L[GL_Q + i * 33 + d] * qs * __expf(bi - bm);
                    L[GL_KE + dir * 2112 + i * 33 + d] = L[GL_K + i * 33 + d] * __expf(bm - bi); }
                { const int idx = tid * 4; const int d = idx >> 6; const f32x4 sv = dir ? Rc.s1 : Rc.s0; const float em = __expf(B[mid * 33 + d]);
                  *(f32x4*)(L + GL_S + dir * 2048 + idx) = sv * em; }
            }
        }
        __syncthreads();
        {
            const int dir = wave >> 2, ih = (wave >> 1) & 1, jh = wave & 1;
            const float* QE = L + GL_QE + dir * 2112 + (32 * ih + i32) * 33 + hi; const float* KE = L + GL_KE + dir * 2112 + (32 * jh + i32) * 33 + hi;
            f32x16 acc;
#pragma unroll
            for (int r = 0; r < 16; ++r) acc[r] = 0.f;
            const bool zero_tile = dir ? (ih == 1 && jh == 0) : (ih == 0 && jh == 1);
            if (!zero_tile) {
#pragma unroll
                for (int kk = 0; kk < 16; ++kk) acc = mfma_f32(QE[2 * kk], KE[2 * kk], acc);
            }
            float* at = L + GL_ATT + dir * 4160 + 32 * jh + i32; const int jg = 32 * jh + i32;
#pragma unroll
            for (int r = 0; r < 16; ++r) { const int ig = 32 * ih + (r & 3) + 8 * (r >> 2) + 4 * hi; const bool keep = dir ? (jg >= ig) : (jg <= ig); at[ig * 65] = keep ? acc[r] : 0.f; }
        }
        __syncthreads();
        {
            const int dir = wave >> 2, ih = (wave >> 1) & 1, vh = wave & 1;
            const float* AT = L + GL_ATT + dir * 4160 + (32 * ih + i32) * 65 + hi; const float* V = L + GL_V + hi * 64 + 32 * vh + i32;
            const float* QE = L + GL_QE + dir * 2112 + (32 * ih + i32) * 33 + hi; const float* S = L + GL_S + dir * 2048 + hi * 64 + 32 * vh + i32;
            f32x16 acc;
#pragma unroll
            for (int r = 0; r < 16; ++r) acc[r] = 0.f;
            const int k0 = (dir == 1 && ih == 1) ? 16 : 0, k1 = (dir == 0 && ih == 0) ? 16 : 32;
#pragma unroll 8
            for (int kk = k0; kk < k1; ++kk) acc = mfma_f32(AT[2 * kk], V[2 * kk * 64], acc);
#pragma unroll
            for (int kk = 0; kk < 16; ++kk) acc = mfma_f32(QE[2 * kk], S[2 * kk * 64], acc);
            float* op = L + GL_OP + dir * 4096 + 32 * vh + i32;
#pragma unroll
            for (int r = 0; r < 16; ++r) { const int ig = 32 * ih + (r & 3) + 8 * (r >> 2) + 4 * hi; op[ig * 64] = acc[r]; }
        }
        __syncthreads();
        {
            const int i = tid >> 3, v8 = (tid & 7) * 8;
            const f32x4 o0 = *(const f32x4*)(L + GL_OP + i * 64 + v8) + *(const f32x4*)(L + GL_OP + 4096 + i * 64 + v8);
            const f32x4 o1 = *(const f32x4*)(L + GL_OP + i * 64 + v8 + 4) + *(const f32x4*)(L + GL_OP + 4096 + i * 64 + v8 + 4);
            float ss = (o0.x * o0.x + o0.y * o0.y) + (o0.z * o0.z + o0.w * o0.w) + (o1.x * o1.x + o1.y * o1.y) + (o1.z * o1.z + o1.w * o1.w);
            ss += shx(ss, 1, lane); ss += shx(ss, 2, lane); ss += shx(ss, 4, lane);
            const float rstd = rsqrtf(ss * (1.f / 64.f) + EPS);
            const float* gn = p->gla_norm + layer * 64 + v8; const f32x4 g0 = *(const f32x4*)gn, g1 = *(const f32x4*)(gn + 4);
            const v4u ogw = Rc.og;
            const float og[8] = {bflo(ogw.x), bfhi(ogw.x), bflo(ogw.y), bfhi(ogw.y), bflo(ogw.z), bfhi(ogw.z), bflo(ogw.w), bfhi(ogw.w)};
            float y[8];
#pragma unroll
            for (int k = 0; k < 4; ++k) { y[k] = o0[k] * rstd * g0[k] * silu_f(og[k]); y[4 + k] = o1[k] * rstd * g1[k] * silu_f(og[4 + k]); }
            v4u w; w.x = pk2(y[0], y[1]); w.y = pk2(y[2], y[3]); w.z = pk2(y[4], y[5]); w.w = pk2(y[6], y[7]);
            *(v4u*)(Y + (size_t)(m0 + i) * DM + 768 + h * 64 + v8) = w;
        }
        __syncthreads();
    }
}

__device__ __forceinline__ void phase_prep(PP p, int layer) {
    const int tid_ = otid(); const int lane = tid_ & 63, wave = tid_ >> 6;
    const int gw = obid() * NWAVES + wave, NGW = gridDim.x * NWAVES;
    const bf16* Z = (const bf16*)(p->ws + WS_Z);
    bf16* Y = (bf16*)(p->ws + WS_H) + (size_t)256 * DM; bf16* AKV = (bf16*)(p->ws + WS_AKV); bf16* AQ = (bf16*)(p->ws + WS_AQ); bf16* Kb = (bf16*)(p->ws + WS_K);
    const float* rope = (const float*)(p->ws + WS_ROPE);
    const float kvn0 = p->kv_norm[layer * 128 + 2 * lane], kvn1 = p->kv_norm[layer * 128 + 2 * lane + 1];
    const f32x4 qn = *(const f32x4*)(p->q_norm + layer * 256 + 4 * lane);
    for (int m = gw; m < MT; m += NGW) {
        const int s = m % SB; const bool isctx = s < CTX; const int pos = isctx ? s : s - CTX, Lq = isctx ? CTX : SEQ; const int mbase = m - pos;
        const bf16* zr = Z + (size_t)m * INP;
        const unsigned wckv = *(const unsigned*)(zr + ZC_CKV + 2 * lane);
        const v2u wcq = *(const v2u*)(zr + ZC_CQ + 4 * lane);
        const int e = lane & 31; const float xv = bf2f(zr[ZC_KR + e]);
        float cs = 1.f, sn = 0.f;
        if (!isctx) { const int axis = e >> 4, f = e & 7; cs = rope[(pos * 16 + axis * 8 + f) * 2]; sn = rope[(pos * 16 + axis * 8 + f) * 2 + 1]; }
        const int g = lane >> 4, w = 2 << g; const int lo0 = pos - w / 2; const int lo = lo0 < 0 ? 0 : lo0; const int hi = (lo0 + w > Lq) ? Lq : lo0 + w;
        v2u pw[16];
#pragma unroll
        for (int r = 0; r < 16; ++r) { const int rr = lo + r; const int rc = (rr < hi) ? rr : pos; pw[r] = *(const v2u*)(Z + (size_t)(mbase + rc) * INP + ZC_POOL + 4 * lane); }
        const v2u pq = *(const v2u*)(zr + ZC_POOL + 4 * lane);
        {
            const float a = bflo(wckv), bq = bfhi(wckv);
            const float rstd = rsqrtf(wave_sum(a * a + bq * bq, lane) * (1.f / 128.f) + EPS);
            *(unsigned*)(AKV + (size_t)m * 256 + 2 * lane) = pk2(a * rstd * kvn0, bq * rstd * kvn1);
            *(unsigned*)(AKV + (size_t)m * 256 + 128 + 2 * lane) = 0u;
        }
        {
            const float a0 = bflo(wcq.x), a1 = bfhi(wcq.x), a2 = bflo(wcq.y), a3 = bfhi(wcq.y);
            const float rstd = rsqrtf(wave_sum((a0 * a0 + a1 * a1) + (a2 * a2 + a3 * a3), lane) * (1.f / 256.f) + EPS);
            v2u o; o.x = pk2(a0 * rstd * qn.x, a1 * rstd * qn.y); o.y = pk2(a2 * rstd * qn.z, a3 * rstd * qn.w);
            *(v2u*)(AQ + (size_t)m * 256 + 4 * lane) = o;
        }
        {
            const float pv = shx(xv, 8, lane); const int half = (e >> 3) & 1;
            const float o = isctx ? xv : xv * cs + (half ? pv : -pv) * sn;
            const float o2 = shdn(o, 1, lane);
            if (lane < 32 && !(lane & 1)) { const unsigned wv = pk2(o, o2);
#pragma unroll
                for (int h = 0; h < 8; ++h) *(unsigned*)(Kb + (size_t)m * 768 + h * 96 + 64 + lane) = wv; }
        }
        {
            float s0 = 0.f, s1 = 0.f, s2 = 0.f, s3 = 0.f;
#pragma unroll
            for (int r = 0; r < 16; ++r) { const float k = (lo + r < hi) ? 1.f : 0.f; s0 += k * bflo(pw[r].x); s1 += k * bfhi(pw[r].x); s2 += k * bflo(pw[r].y); s3 += k * bfhi(pw[r].y); }
            const float inv = 1.f / (float)(hi - lo);
            v2u o; o.x = pk2(s0 * inv - bflo(pq.x), s1 * inv - bfhi(pq.x)); o.y = pk2(s2 * inv - bflo(pq.y), s3 * inv - bfhi(pq.y));
            *(v2u*)(Y + (size_t)m * DM + 4 * lane) = o;
        }
    }
}
typedef float f32x2_t __attribute__((ext_vector_type(2))); typedef __bf16 bf16x2_t __attribute__((ext_vector_type(2)));
__device__ __forceinline__ unsigned cvtpk(float lo, float hi) { f32x2_t v = {lo, hi}; bf16x2_t b = __builtin_convertvector(v, bf16x2_t); return __builtin_bit_cast(unsigned, b); }
#ifndef AT_VG
#define AT_VG 6
#endif
constexpr int AT_KROW = 208, AT_VROW = 144, AT_KB = 64 * AT_KROW, AT_VB = 64 * AT_VROW, AT_BUF = AT_KB + AT_VB;
__device__ __forceinline__ void phase_attn(PP p, int layer, unsigned char* lds) {
    const int tid = otid(), lane = tid & 63, wave = tid >> 6, i32 = lane & 31, hi = lane >> 5;
    const bf16* Qb = (const bf16*)(p->ws + WS_Q); const bf16* Kb = (const bf16*)(p->ws + WS_K); const bf16* Vt = (const bf16*)(p->ws + WS_VT);
    bf16* Y = (bf16*)(p->ws + WS_H) + (size_t)256 * DM; const float* rope = (const float*)(p->ws + WS_ROPE);
    const int G = gridDim.x; const int bx = obid(); const int vcu = (G % 8 == 0) ? (bx % 8) * (G / 8) + bx / 8 : bx;
    const int nunits = (layer == DEPTH - 1) ? 2048 : 2048 + 128;
    const int pi = (i32 & ~12) | ((i32 & 4) << 1) | ((i32 & 8) >> 1);
    const int kp1_i = (512 + tid) < 768 ? (512 + tid) : 767; const int kp0_row = tid / 12, kp0_c = tid % 12, kp1_row = kp1_i / 12, kp1_c = kp1_i % 12;
    const int vp_d = tid >> 3, vp_c = tid & 7;
    for (int u = vcu; u < nunits; u += G) {
        int b, h, q_m0, kv_m0, NT, qpos0; bool lat;
        if (u < 2048) { const int bh = u >> 4, qb = u & 15; b = bh >> 3; h = bh & 7; q_m0 = b * SB + CTX + qb * 256; kv_m0 = b * SB; NT = 68; qpos0 = qb * 256; lat = true; }
        else { const int uc = u - 2048; b = uc >> 3; h = uc & 7; q_m0 = b * SB; kv_m0 = b * SB; NT = 4; qpos0 = 0; lat = false; }
        const bf16* kg0 = Kb + (size_t)(kv_m0 + kp0_row) * 768 + h * 96 + kp0_c * 8;
        const bf16* kg1 = Kb + (size_t)(kv_m0 + kp1_row) * 768 + h * 96 + kp1_c * 8;
        const bf16* vg = Vt + (size_t)(h * 64 + vp_d) * MT + kv_m0 + vp_c * 8;
        bf16x8 qf[6];
        v4u pr[4][3];
        {
            const int qm = q_m0 + wave * 32 + i32; const bf16* qr = Qb + (size_t)qm * 768 + h * 96 + hi * 8;
#pragma unroll
            for (int d0 = 0; d0 < 6; ++d0) qf[d0] = *(const bf16x8*)(qr + d0 * 16);
#pragma unroll
            for (int tt = 0; tt < 4; ++tt) { pr[tt][0] = *(const v4u*)(kg0 + (size_t)tt * 64 * 768); pr[tt][1] = *(const v4u*)(kg1 + (size_t)tt * 64 * 768); pr[tt][2] = *(const v4u*)(vg + tt * 64); }
        }
        {
            if (lat) {
                const int pos = qpos0 + wave * 32 + i32;
#pragma unroll
                for (int a = 0; a < 2; ++a) {
                    v4u w = __builtin_bit_cast(v4u, qf[4 + a]); v4u pw;
                    pw.x = shxu(w.x, 32, lane); pw.y = shxu(w.y, 32, lane); pw.z = shxu(w.z, 32, lane); pw.w = shxu(w.w, 32, lane);
                    const float* rp = rope + (size_t)(pos * 16 + a * 8) * 2;
                    float xv[8], pv[8], ov[8];
                    xv[0] = bflo(w.x); xv[1] = bfhi(w.x); xv[2] = bflo(w.y); xv[3] = bfhi(w.y); xv[4] = bflo(w.z); xv[5] = bfhi(w.z); xv[6] = bflo(w.w); xv[7] = bfhi(w.w);
                    pv[0] = bflo(pw.x); pv[1] = bfhi(pw.x); pv[2] = bflo(pw.y); pv[3] = bfhi(pw.y); pv[4] = bflo(pw.z); pv[5] = bfhi(pw.z); pv[6] = bflo(pw.w); pv[7] = bfhi(pw.w);
#pragma unroll
                    for (int f = 0; f < 8; ++f) { const float cs = rp[2 * f], sn = rp[2 * f + 1]; ov[f] = xv[f] * cs + (hi ? pv[f] : -pv[f]) * sn; }
                    v4u o; o.x = pk2(ov[0], ov[1]); o.y = pk2(ov[2], ov[3]); o.z = pk2(ov[4], ov[5]); o.w = pk2(ov[6], ov[7]);
                    qf[4 + a] = __builtin_bit_cast(bf16x8, o);
                }
            }
        }
        v4u rk0, rk1 = {0u, 0u, 0u, 0u}, rv, sk0, sk1 = {0u, 0u, 0u, 0u}, sv;
#define AT_LOAD(tt) do { rk0 = *(const v4u*)(kg0 + (size_t)(tt) * 64 * 768); rk1 = *(const v4u*)(kg1 + (size_t)(tt) * 64 * 768); rv = *(const v4u*)(vg + (tt) * 64); } while (0)
#define AT_LOAD2(tt) do { sk0 = *(const v4u*)(kg0 + (size_t)(tt) * 64 * 768); sk1 = *(const v4u*)(kg1 + (size_t)(tt) * 64 * 768); sv = *(const v4u*)(vg + (tt) * 64); } while (0)
#define AT_STORE2(bufi) do { unsigned char* kn_ = lds + (bufi) * AT_BUF; *(v4u*)(kn_ + kp0_row * AT_KROW + kp0_c * 16) = sk0; if (tid < 256) *(v4u*)(kn_ + kp1_row * AT_KROW + kp1_c * 16) = sk1; \
            *(v4u*)(kn_ + AT_KB + vp_d * AT_VROW + vp_c * 16) = sv; } while (0)
#define AT_STORE(bufi) do { unsigned char* kn_ = lds + (bufi) * AT_BUF; *(v4u*)(kn_ + kp0_row * AT_KROW + kp0_c * 16) = rk0; if (tid < 256) *(v4u*)(kn_ + kp1_row * AT_KROW + kp1_c * 16) = rk1; \
            *(v4u*)(kn_ + AT_KB + vp_d * AT_VROW + vp_c * 16) = rv; } while (0)
#define AT_QK(bufi, P0, P1) do { const unsigned char* ka_ = lds + (bufi) * AT_BUF + pi * AT_KROW + hi * 16; P0 = negm; P1 = negm; \
            _Pragma("unroll") for (int d0 = 0; d0 < 6; ++d0) { const bf16x8 a0 = *(const bf16x8*)(ka_ + d0 * 32); const bf16x8 a1 = *(const bf16x8*)(ka_ + 32 * AT_KROW + d0 * 32); \
                P0 = __builtin_amdgcn_mfma_f32_32x32x16_bf16(a0, qf[d0], P0, 0, 0, 0); P1 = __builtin_amdgcn_mfma_f32_32x32x16_bf16(a1, qf[d0], P1, 0, 0, 0); } } while (0)
#define AT_PV(bufi) do { const unsigned char* va_ = lds + (bufi) * AT_BUF + AT_KB + i32 * AT_VROW + hi * 16; \
            _Pragma("unroll") for (int ks = 0; ks < 4; ++ks) { const bf16x8 v0 = *(const bf16x8*)(va_ + ks * 32); const bf16x8 v1 = *(const bf16x8*)(va_ + 32 * AT_VROW + ks * 32); \
                o0 = __builtin_amdgcn_mfma_f32_32x32x16_bf16(v0, pk[ks], o0, 0, 0, 0); o1 = __builtin_amdgcn_mfma_f32_32x32x16_bf16(v1, pk[ks], o1, 0, 0, 0); } } while (0)
#define AT_SOFTMAX(FIRST, HAVE_NEXT) do { \
            f32x16 e0, e1; float rs0 = 0.f, rs1 = 0.f; \
            _Pragma("unroll") for (int r = 0; r < 16; ++r) { e0[r] = __builtin_amdgcn_exp2f(pc0[r]); e1[r] = __builtin_amdgcn_exp2f(pc1[r]); rs0 += e0[r]; rs1 += e1[r]; } \
            asm volatile("" : "+v"(e0), "+v"(e1), "+v"(rs0), "+v"(rs1)); \
            if (HAVE_NEXT) { _Pragma("unroll") for (int g_ = 0; g_ < 12; ++g_) { __builtin_amdgcn_sched_group_barrier(0x100, 1, 0); __builtin_amdgcn_sched_group_barrier(0x008, 1, 0); __builtin_amdgcn_sched_group_barrier(0x402, AT_VG, 0); } } \
              \
            if (__builtin_expect(__any((FIRST) || !(rs0 + rs1 <= 8192.0f)), 0)) { \
                float mx = fmaxf(fmaxf(pc0[0], pc1[0]), fmaxf(pc0[1], pc1[1])); \
                _Pragma("unroll") for (int r = 2; r < 16; r += 2) mx = fmaxf(mx, fmaxf(fmaxf(pc0[r], pc1[r]), fmaxf(pc0[r + 1], pc1[r + 1]))); \
                mx = fmaxf(mx, shx(mx, 32, lane)); \
                const float delta = ((FIRST) || mx > 8.0f) ? mx : 0.f; m_run += delta; const float alpha = __builtin_amdgcn_exp2f(-delta); l_run *= alpha; rs0 = 0.f; rs1 = 0.f; \
                _Pragma("unroll") for (int r = 0; r < 16; ++r) { e0[r] = __builtin_amdgcn_exp2f(pc0[r] - delta); e1[r] = __builtin_amdgcn_exp2f(pc1[r] - delta); rs0 += e0[r]; rs1 += e1[r]; \
                    o0[r] *= alpha; o1[r] *= alpha; negm[r] = -m_run; if (HAVE_NEXT) { pn0[r] -= delta; pn1[r] -= delta; } } \
            } \
            l_run += rs0 + rs1; \
            { v4u w; \
              w.x = cvtpk(e0[0], e0[1]); w.y = cvtpk(e0[2], e0[3]); w.z = cvtpk(e0[4], e0[5]); w.w = cvtpk(e0[6], e0[7]); pk[0] = __builtin_bit_cast(bf16x8, w); \
              w.x = cvtpk(e0[8], e0[9]); w.y = cvtpk(e0[10], e0[11]); w.z = cvtpk(e0[12], e0[13]); w.w = cvtpk(e0[14], e0[15]); pk[1] = __builtin_bit_cast(bf16x8, w); \
              w.x = cvtpk(e1[0], e1[1]); w.y = cvtpk(e1[2], e1[3]); w.z = cvtpk(e1[4], e1[5]); w.w = cvtpk(e1[6], e1[7]); pk[2] = __builtin_bit_cast(bf16x8, w); \
              w.x = cvtpk(e1[8], e1[9]); w.y = cvtpk(e1[10], e1[11]); w.z = cvtpk(e1[12], e1[13]); w.w = cvtpk(e1[14], e1[15]); pk[3] = __builtin_bit_cast(bf16x8, w); } \
        } while (0)
        __syncthreads();
#pragma unroll
        for (int tt = 0; tt < 4; ++tt) { rk0 = pr[tt][0]; rk1 = pr[tt][1]; rv = pr[tt][2]; AT_STORE(tt); }
        __syncthreads();
        f32x16 o0, o1, negm, pc0, pc1, pn0, pn1;
#pragma unroll
        for (int r = 0; r < 16; ++r) { o0[r] = 0.f; o1[r] = 0.f; negm[r] = 0.f; pn0[r] = 0.f; pn1[r] = 0.f; }
        float m_run = 0.f, l_run = 0.f;
        bf16x8 pk[4];
        AT_QK(0, pc0, pc1);
        {
            float mx = fmaxf(fmaxf(pc0[0], pc1[0]), fmaxf(pc0[1], pc1[1]));
#pragma unroll
            for (int r = 2; r < 16; r += 2) mx = fmaxf(mx, fmaxf(fmaxf(pc0[r], pc1[r]), fmaxf(pc0[r + 1], pc1[r + 1])));
            mx = fmaxf(mx, shx(mx, 32, lane)); m_run = mx;
#pragma unroll
            for (int r = 0; r < 16; ++r) { pc0[r] -= mx; pc1[r] -= mx; negm[r] = -mx; }
        }
        int s0 = 0;
#pragma unroll 1
        for (int tau = 0; tau < NT - 2; tau += 2) {
            const int s1 = s0 + 1, s2 = (s0 + 2 >= 6) ? s0 - 4 : s0 + 2, s4 = (s0 + 4 >= 6) ? s0 - 2 : s0 + 4;
            const int tl = (tau + 4 < NT) ? tau + 4 : NT - 2;
            AT_LOAD(tl);
            AT_QK(s1, pn0, pn1);
            AT_SOFTMAX(false, true);
            AT_PV(s0);
            pc0 = pn0; pc1 = pn1;
            AT_STORE(s4);
            AT_LOAD(tl + 1);
            AT_QK(s2, pn0, pn1);
            AT_SOFTMAX(false, true);
            AT_PV(s1);
            pc0 = pn0; pc1 = pn1;
            AT_STORE(s4 + 1);
            __syncthreads();
            s0 = s2;
        }
        {
            AT_QK(s0 + 1, pn0, pn1);
            AT_SOFTMAX(false, true);
            AT_PV(s0);
            pc0 = pn0; pc1 = pn1;
            AT_SOFTMAX(false, false);
            AT_PV(s0 + 1);
        }
#undef AT_LOAD2
#undef AT_STORE2
#undef AT_LOAD
#undef AT_STORE
#undef AT_QK
#undef AT_PV
#undef AT_SOFTMAX
        {
            const float l = l_run + shx(l_run, 32, lane); const float inv = 1.f / l;
            bf16* yr = Y + (size_t)(q_m0 + wave * 32 + i32) * DM + 256 + h * 64;
#pragma unroll
            for (int g = 0; g < 4; ++g) {
                const int d = 8 * g + 4 * hi;
                v2u w0; w0.x = pk2(o0[4 * g] * inv, o0[4 * g + 1] * inv); w0.y = pk2(o0[4 * g + 2] * inv, o0[4 * g + 3] * inv); *(v2u*)(yr + d) = w0;
                v2u w1; w1.x = pk2(o1[4 * g] * inv, o1[4 * g + 1] * inv); w1.y = pk2(o1[4 * g + 2] * inv, o1[4 * g + 3] * inv); *(v2u*)(yr + 32 + d) = w1;
            }
        }
    }
    __syncthreads();
}

__device__ __forceinline__ void phase_final(PP p) {
    const int tid_ = otid(); const int lane = tid_ & 63, wave = tid_ >> 6;
    const int gw = obid() * NWAVES + wave, NGW = gridDim.x * NWAVES;
    f32x4 g4[4];
#pragma unroll
    for (int j = 0; j < 4; ++j) g4[j] = *(const f32x4*)(p->norm_f + 4 * lane + 256 * j);
    for (int r0 = gw; r0 < NB * SEQ; r0 += 2 * NGW) {
        int rr[2]; rr[0] = r0; rr[1] = (r0 + NGW < NB * SEQ) ? r0 + NGW : r0;
        f32x4 v[2][4]; float ss[2];
#pragma unroll
        for (int u = 0; u < 2; ++u) { const float* xr = p->out + (size_t)rr[u] * DM;
#pragma unroll
            for (int j = 0; j < 4; ++j) v[u][j] = *(const f32x4*)(xr + 4 * lane + 256 * j); }
#pragma unroll
        for (int u = 0; u < 2; ++u) { float a = 0.f;
#pragma unroll
            for (int j = 0; j < 4; ++j) a += (v[u][j].x * v[u][j].x + v[u][j].y * v[u][j].y) + (v[u][j].z * v[u][j].z + v[u][j].w * v[u][j].w);
            ss[u] = a; }
#pragma unroll
        for (int o = 1; o < 64; o <<= 1) { ss[0] += shx(ss[0], o, lane); ss[1] += shx(ss[1], o, lane); }
#pragma unroll
        for (int u = 0; u < 2; ++u) {
            if (u == 1 && rr[1] == r0) break;
            float* xr = p->out + (size_t)rr[u] * DM; const float rstd = rsqrtf(ss[u] * (1.f / DM) + EPS);
#pragma unroll
            for (int j = 0; j < 4; ++j) __builtin_nontemporal_store(v[u][j] * rstd * g4[j], (f32x4*)(xr + 4 * lane + 256 * j));
        }
    }
}


#ifdef DIAG
__device__ __forceinline__ void diag_reduce(PP p, float num, float den, unsigned char* lds) {
    float* L = (float*)lds; const int tid = otid();
    L[tid] = num; L[512 + tid] = den; __syncthreads();
    if (tid == 0) { float a = 0.f, b = 0.f; for (int i = 0; i < 512; ++i) { a += L[i]; b += L[512 + i]; } float* dg = (float*)(p->ws + WS_DIAG); dg[0] = a; dg[1] = b; }
    __syncthreads();
}
__device__ __forceinline__ void diag_ffn_up(PP p, int layer, unsigned char* lds) {
    if (obid() != 0) return;
    const int tid = otid(); float num = 0.f, den = 0.f;
    if (tid < 256) {
#ifdef DIAG_EDGE
        const int ek = (tid >> 4) & 7; const int es = ek == 0 ? 0 : ek == 1 ? 255 : ek == 2 ? 256 : ek == 3 ? 4351 : ek == 4 ? 1 : ek == 5 ? 254 : ek == 6 ? 257 : 4350;
        const int tok = (tid & 15) * SB + es, c = (tid * 97 + 5) % DFF; const int s = tok % SB;
#else
        const int tok = (tid * 271 + 13) % MT, c = (tid * 97 + 5) % DFF; const int s = tok % SB;
#endif
        const bf16* H = (const bf16*)(p->ws + WS_H) + (size_t)256 * DM; const float* W = p->w_up + (size_t)layer * DM * 2 * DFF;
        float u = 0.f, g0 = 0.f, gm = 0.f, gp = 0.f;
        for (int k = 0; k < DM; ++k) { const float wu = W[(size_t)k * 2 * DFF + c], wg = W[(size_t)k * 2 * DFF + DFF + c];
            u += bf2f(H[(size_t)tok * DM + k]) * wu; g0 += bf2f(H[(size_t)tok * DM + k]) * wg;
            if (!(s == 0 || s == 256)) gm += bf2f(H[(size_t)(tok - 1) * DM + k]) * wg;
            if (!(s == 255 || s == 4351)) gp += bf2f(H[(size_t)(tok + 1) * DM + k]) * wg; }
        const float* cw = p->conv_w + (size_t)layer * 3 * DFF; const float gc = cw[c] * gm + cw[DFF + c] * g0 + cw[2 * DFF + c] * gp + p->conv_b[layer * DFF + c];
        float ref = gc / (1.f + expf(-gc)) * u;
#ifdef UP_U
        ref = u;
#endif
#ifdef UP_G
        ref = g0;
#endif
#ifdef UP_GC
        ref = gc;
#endif
#ifdef UP_GP
        ref = gm;
#endif
#ifdef UP_GN
        ref = gp;
#endif
 const float mine = bf2f(((const bf16*)(p->ws + WS_AFF))[(size_t)tok * DFF + c]);
        num = (ref - mine) * (ref - mine); den = ref * ref;
    }
    diag_reduce(p, num, den, lds);
}
#endif

#if defined(DIAG) && DIAG == 2
__device__ __forceinline__ void diag_attn(PP p, int layer, unsigned char* lds) {
    const int tid = otid(); const int sidx = obid();
    float* L = (float*)lds;
    float* Wkv = L;
    float* qv = L + 16384;
    float* sc = L + 16384 + 128;
    float* red = L + 16384 + 128 + 4352;
    float* oacc = red + 512;
    const bf16* Z = (const bf16*)(p->ws + WS_Z); const float* rope = (const float*)(p->ws + WS_ROPE);
    #ifdef DIAG_CTX
    const int b = sidx % NB, h = (sidx / NB) % 8, pos = (sidx * 37 + 11) % CTX; const int mq = b * SB + pos; const int NK = CTX; const bool qrope = false;
#else
    const int b = sidx % NB, h = (sidx / NB) % 8, pos = (sidx * 37 + 11) % SEQ; const int mq = b * SB + CTX + pos; const int NK = SB; const bool qrope = true;
#endif
    for (int i = tid; i < 128 * 128; i += NTHREADS) Wkv[i] = p->w_ukv[(size_t)layer * 128 * 1024 + (size_t)(i >> 7) * 1024 + h * 128 + (i & 127)];
    if (tid < 96) {
        float ss = 0.f; for (int k = 0; k < 256; ++k) { const float v = bf2f(Z[(size_t)mq * INP + ZC_CQ + k]); ss += v * v; }
        const float rstd = rsqrtf(ss / 256.f + EPS); float a = 0.f;
        for (int k = 0; k < 256; ++k) a += bf2f(Z[(size_t)mq * INP + ZC_CQ + k]) * rstd * p->q_norm[layer * 256 + k] * p->w_uq[(size_t)layer * 256 * 768 + (size_t)k * 768 + h * 96 + tid];
        qv[tid] = a;
    }
    __syncthreads();
    {
        float o = 0.f;
        if (tid < 32 && qrope) { const int e = tid, axis = e >> 4, half = (e >> 3) & 1, f = e & 7; const float x = qv[64 + e], px = qv[64 + (e ^ 8)];
            const float cs = rope[(pos * 16 + axis * 8 + f) * 2], sn = rope[(pos * 16 + axis * 8 + f) * 2 + 1];
            o = x * cs + (half ? px : -px) * sn; }
        __syncthreads();
        if (tid < 32 && qrope) qv[64 + tid] = o;
    }
    __syncthreads();
    float lmax = -1e30f;
    for (int j = tid; j < NK; j += NTHREADS) {
        const bf16* zr = Z + (size_t)(b * SB + j) * INP; float ss = 0.f;
        for (int k = 0; k < 128; ++k) { const float v = bf2f(zr[ZC_CKV + k]); ss += v * v; }
        const float rstd = rsqrtf(ss / 128.f + EPS); float s = 0.f;
        for (int d = 0; d < 64; ++d) { float kn = 0.f; for (int k = 0; k < 128; ++k) kn += bf2f(zr[ZC_CKV + k]) * rstd * p->kv_norm[layer * 128 + k] * Wkv[k * 128 + d]; s += kn * qv[d]; }
        for (int e = 0; e < 32; ++e) { const int axis = e >> 4, half = (e >> 3) & 1, f = e & 7; float x = bf2f(zr[ZC_KR + e]);
            if (j >= CTX) { const int kp = j - CTX; const float px = bf2f(zr[ZC_KR + (e ^ 8)]); const float cs = rope[(kp * 16 + axis * 8 + f) * 2], sn = rope[(kp * 16 + axis * 8 + f) * 2 + 1]; x = x * cs + (half ? px : -px) * sn; }
            s += x * qv[64 + e]; }
        s *= 0.10206207261596575f; sc[j] = s; lmax = fmaxf(lmax, s);
    }
    red[tid] = lmax; __syncthreads();
    if (tid == 0) { float m = -1e30f; for (int i = 0; i < NTHREADS; ++i) m = fmaxf(m, red[i]); red[0] = m; }
    __syncthreads(); const float gmax = red[0]; __syncthreads();
    float lsum = 0.f; for (int j = tid; j < NK; j += NTHREADS) { const float e = expf(sc[j] - gmax); sc[j] = e; lsum += e; }
    red[tid] = lsum; __syncthreads();
    if (tid == 0) { float s = 0.f; for (int i = 0; i < NTHREADS; ++i) s += red[i]; red[0] = s; }
    __syncthreads(); const float gsum = red[0]; __syncthreads();
    { const int d = tid & 63, grp = tid >> 6; float o = 0.f;
      for (int j = grp; j < NK; j += 8) { const bf16* zr = Z + (size_t)(b * SB + j) * INP; float ss = 0.f;
          for (int k = 0; k < 128; ++k) { const float v = bf2f(zr[ZC_CKV + k]); ss += v * v; }
          const float rstd = rsqrtf(ss / 128.f + EPS); float vv = 0.f;
          for (int k = 0; k < 128; ++k) vv += bf2f(zr[ZC_CKV + k]) * rstd * p->kv_norm[layer * 128 + k] * Wkv[k * 128 + 64 + d];
          o += sc[j] * vv; }
      oacc[grp * 64 + d] = o; }
    __syncthreads();
    float num = 0.f, den = 0.f;
    if (tid < 64) { float o = 0.f; for (int g = 0; g < 8; ++g) o += oacc[g * 64 + tid]; o /= gsum;
        const float mine = bf2f(((const bf16*)(p->ws + WS_H) + (size_t)256 * DM)[(size_t)mq * DM + 256 + h * 64 + tid]);
        num = (o - mine) * (o - mine); den = o * o; }
    red[tid] = num; __syncthreads();
    if (tid == 0) { float s = 0.f; for (int i = 0; i < 64; ++i) s += red[i]; atomicAdd((float*)(p->ws + WS_DIAG), s); }
    __syncthreads(); red[tid] = den; __syncthreads();
    if (tid == 0) { float s = 0.f; for (int i = 0; i < 64; ++i) s += red[i]; atomicAdd((float*)(p->ws + WS_DIAG) + 1, s); }
    __syncthreads();
}
#endif

#if defined(DIAG) && DIAG == 4
__device__ __forceinline__ void diag_z(PP p, unsigned char* lds) {
    if (obid() != 0) return;
    const int tid = otid(); float num = 0.f, den = 0.f;
    {
        const int m = (tid * 1361 + 7) % MT, n = (tid * 37 + 3) % INC; const int b = m / SB, s = m % SB;
        const float* xr = (s < CTX) ? p->ctx + ((size_t)b * CTX + s) * DM : p->x + ((size_t)b * SEQ + (s - CTX)) * DM;
        const float* mod = (s < CTX) ? (const float*)(p->ws + WS_ADAC) : (const float*)(p->ws + WS_ADAL) + (size_t)b * 6144;
        float ss = 0.f; for (int k = 0; k < DM; ++k) ss += xr[k] * xr[k];
        const float rstd = 1.f / sqrtf(ss / DM + EPS); float a = 0.f;
        for (int k = 0; k < DM; ++k) { const float h = xr[k] * rstd * p->norm1[k] * (1.f + mod[DM + k]) + mod[k]; a += h * p->w_in[(size_t)k * INC + n]; }
        const float mine = bf2f(((const bf16*)(p->ws + WS_Z))[(size_t)m * INP + n]);
        num = (a - mine) * (a - mine); den = a * a;
    }
    diag_reduce(p, num, den, lds);
}
#endif
#if defined(DIAG) && DIAG == 5
__device__ __forceinline__ void diag_wo(PP p, unsigned char* lds) {
    if (obid() != 0) return;
    const int tid = otid(); float num = 0.f, den = 0.f;
    {
        const int r = (tid * 127 + 5) % (NB * SEQ), n = (tid * 37 + 3) % DM; const int b = r / SEQ, pos = r % SEQ; const int m = b * SB + CTX + pos;
        const bf16* y = (const bf16*)(p->ws + WS_H) + (size_t)256 * DM + (size_t)m * DM;
        float a = 0.f;
        for (int g = 0; g < 4; ++g) for (int d = 0; d < 64; ++d) { float yy = 0.f; for (int c = 0; c < 64; ++c) yy += bf2f(y[g * 64 + c]) * p->w_pool[(size_t)g * 4096 + c * 64 + d];
            a += yy * p->pool_scale[g * 64 + d] * p->w_o[(size_t)(g * 64 + d) * DM + n]; }
        for (int k = 256; k < DM; ++k) a += bf2f(y[k]) * p->w_o[(size_t)k * DM + n];
        const float gate = ((const float*)(p->ws + WS_ADAL))[(size_t)b * 6144 + 2 * DM + n];
        const float delta = gate * a; const float mine = p->out[(size_t)r * DM + n] - p->x[(size_t)r * DM + n];
        num = (delta - mine) * (delta - mine); den = delta * delta;
    }
    diag_reduce(p, num, den, lds);
}
#endif

#if defined(DIAG) && DIAG == 6
__device__ __forceinline__ void diag_ada(PP p, unsigned char* lds) {
    if (obid() != 0) return;
    const int tid = otid(); float num = 0.f, den = 0.f;
    {
        const int L = tid & 3, r = (tid >> 2) % 17, j = (tid * 193 + 11) % 6144;
        float a = p->b_ada[L * 6144 + j], comp = 0.f;
        for (int k = 0; k < DM; ++k) { const float cv = (r < 16) ? p->c[r * DM + k] : p->c_ctx[k]; const float sv = cv / (1.f + expf(-cv));
            const float term = sv * p->w_ada[((size_t)L * DM + k) * 6144 + j]; const float y = term - comp; const float tt = a + y; comp = (tt - a) - y; a = tt; }
        const float mine = (r < 16) ? ((const float*)(p->ws + WS_ADAL))[((size_t)L * NB + r) * 6144 + j] : ((const float*)(p->ws + WS_ADAC))[(size_t)L * 6144 + j];
        num = (a - mine) * (a - mine); den = a * a;
    }
    diag_reduce(p, num, den, lds);
}
#endif

#if defined(DIAG) && DIAG == 7
__device__ __forceinline__ void diag_pool(PP p, unsigned char* lds) {
    if (obid() != 0) return;
    const int tid = otid(); float num = 0.f, den = 0.f;
    {
        const int b = tid & 15; const int k = (tid >> 4) & 31; const int ch = (tid * 37 + 5) & 255;
        const int svals[32] = {0, 1, 2, 3, 7, 8, 9, 15, 16, 100, 246, 247, 248, 253, 254, 255, 256, 257, 258, 263, 264, 265, 272, 1000, 2000, 3000, 4336, 4343, 4344, 4349, 4350, 4351};
        int s = 0;
#pragma unroll
        for (int i = 0; i < 32; ++i) if (i == k) s = svals[i];
        const int m = b * SB + s; const bool isctx = s < CTX; const int pos = isctx ? s : s - CTX, Lq = isctx ? CTX : SEQ, mbase = m - pos;
        const int g = ch >> 6, w = 2 << g; int lo = pos - w / 2, hi = lo + w; lo = lo < 0 ? 0 : lo; hi = hi > Lq ? Lq : hi;
        const bf16* Z = (const bf16*)(p->ws + WS_Z);
        float sum = 0.f; for (int r = lo; r < hi; ++r) sum += bf2f(Z[(size_t)(mbase + r) * INP + ZC_POOL + ch]);
        const float ref = sum / (float)(hi - lo) - bf2f(Z[(size_t)m * INP + ZC_POOL + ch]);
        const float mine = bf2f(((const bf16*)(p->ws + WS_H) + (size_t)256 * DM)[(size_t)m * DM + ch]);
        num = (ref - mine) * (ref - mine); den = ref * ref;
    }
    diag_reduce(p, num, den, lds);
}
#endif

#if defined(DIAG) && DIAG == 8
__device__ __forceinline__ void diag_down_a(PP p, int layer) {
    if (obid() != 0) return;
    const int tid = otid();
    const int r = (tid * 127 + 5) % (NB * SEQ), n = (tid * 37 + 3) % DM; const int b = r / SEQ, pos = r % SEQ; const int m = b * SB + CTX + pos;
    const bf16* a = (const bf16*)(p->ws + WS_AFF) + (size_t)m * DFF; const float* W = p->w_down + (size_t)layer * DFF * DM;
    float acc = 0.f; for (int k = 0; k < DFF; ++k) acc += bf2f(a[k]) * W[(size_t)k * DM + n];
    const float gate = ((const float*)(p->ws + WS_ADAL))[((size_t)layer * NB + b) * 6144 + 5 * DM + n];
    ((float*)(p->ws + WS_DIAG2))[tid] = gate * acc; ((float*)(p->ws + WS_DIAG2))[512 + tid] = p->out[(size_t)r * DM + n];
}
__device__ __forceinline__ void diag_down_b(PP p, unsigned char* lds) {
    if (obid() != 0) return;
    const int tid = otid();
    const int r = (tid * 127 + 5) % (NB * SEQ), n = (tid * 37 + 3) % DM;
    const float delta = ((const float*)(p->ws + WS_DIAG2))[tid], x1 = ((const float*)(p->ws + WS_DIAG2))[512 + tid];
    const float mine = p->out[(size_t)r * DM + n] - x1;
    diag_reduce(p, (delta - mine) * (delta - mine), delta * delta, lds);
}
#endif
#ifndef WO_SCALE
#define WO_SCALE 1.f
#endif
#ifndef DN_SCALE
#define DN_SCALE 1.f
#endif
#define LAS __attribute__((address_space(3)))
#define XB_TMO      128
#define XB_XCNT(j)  (256  + 64 * (j))
#define XB_XSUB(j)  (1280 + 64 * (j))
#define XB_XGEN(j)  (2304 + 64 * (j))
#define XB_TOP      3328
#define XB_TOPGEN   3392
#define XCD_BAR_WORDS 3456
#define XB_SPIN_CAP (1u << 18)

__device__ __forceinline__ unsigned xb_ld(unsigned* p)              { return __hip_atomic_load(p, __ATOMIC_RELAXED, __HIP_MEMORY_SCOPE_AGENT); }
__device__ __forceinline__ unsigned xb_add(unsigned* p, unsigned v) { return __hip_atomic_fetch_add(p, v, __ATOMIC_RELAXED, __HIP_MEMORY_SCOPE_AGENT); }
__device__ __forceinline__ unsigned xb_xcc_id() { return (unsigned)__builtin_amdgcn_s_getreg((3 << 11) | 20) & 0xFu; }
#define XB_SPIN(cond, bar) do { unsigned _sp = 0; while (cond) { __builtin_amdgcn_s_sleep(1); \
    if ((++_sp & 255u) == 0u) { if (xb_ld(&(bar)[XB_TMO])) break; if (_sp > XB_SPIN_CAP) { atomicAdd(&(bar)[XB_TMO], 1u); break; } } } } while (0)

struct XcdBarrier {
    unsigned* bar; unsigned x;
    volatile LAS unsigned* st;
};

__device__ __forceinline__ XcdBarrier xcd_barrier_post(unsigned* bar, volatile LAS unsigned* st) {
    XcdBarrier b; b.bar = bar; b.x = xb_xcc_id(); b.st = st;
    if (threadIdx.x == 0) (void)xb_add(&bar[XB_XCNT(b.x)], 1u);
    return b;
}
__device__ __forceinline__ void xcd_barrier_complete(unsigned* bar, unsigned x, unsigned& nloc, unsigned& nx) {
    const unsigned G = gridDim.x * gridDim.y * gridDim.z;
    unsigned sum, cnt, mine, sp = 0u;
    for (;;) {
        sum = 0u; cnt = 0u; mine = 0u;
#pragma unroll
        for (unsigned j = 0; j < 16; ++j) { const unsigned c = xb_ld(&bar[XB_XCNT(j)]); sum += c; cnt += (c > 0u) ? 1u : 0u; mine = (j == x) ? c : mine; }
        if (sum == G) break;
        __builtin_amdgcn_s_sleep(1);
        if ((++sp & 255u) == 0u) { if (xb_ld(&bar[XB_TMO])) break; if (sp > XB_SPIN_CAP) { atomicAdd(&bar[XB_TMO], 1u); break; } }
    }
    nloc = mine > 0u ? mine : 1u; nx = cnt > 0u ? cnt : 1u;
}

__device__ __forceinline__ void xcd_barrier(const XcdBarrier& b) {
    asm volatile("s_waitcnt vmcnt(0)" ::: "memory");
    __syncthreads();
    if (threadIdx.x == 0) {
        unsigned* bar = b.bar;
        __builtin_amdgcn_s_waitcnt(0);
        unsigned nloc = b.st[0], nx = b.st[1];
        if (nloc == 0u) { xcd_barrier_complete(bar, b.x, nloc, nx); b.st[0] = nloc; b.st[1] = nx; }
        const unsigned old = xb_add(&bar[XB_XSUB(b.x)], 1u);
        const unsigned gen = old / nloc;
        if (old + 1u == (gen + 1u) * nloc) {
            __builtin_amdgcn_fence(__ATOMIC_RELEASE, "agent");
            asm volatile("s_waitcnt vmcnt(0)" ::: "memory");
            const unsigned og = xb_add(&bar[XB_TOP], 1u);
            const unsigned tg = og / nx;
            if (og + 1u == (tg + 1u) * nx) xb_add(&bar[XB_TOPGEN], 1u);
            else XB_SPIN(xb_ld(&bar[XB_TOPGEN]) == tg, bar);
            __builtin_amdgcn_fence(__ATOMIC_ACQUIRE, "agent");
            xb_add(&bar[XB_XGEN(b.x)], 1u);
            asm volatile("s_waitcnt vmcnt(0)" ::: "memory");
        } else {
            XB_SPIN(xb_ld(&bar[XB_XGEN(b.x)]) == gen, bar);
            __builtin_amdgcn_fence(__ATOMIC_ACQUIRE, "agent");
            asm volatile("s_waitcnt vmcnt(0)" ::: "memory");
        }
    }
    __syncthreads();
}

#define LAUNDER() asm volatile("" : "+s"(p) :: "memory")
__global__ void __launch_bounds__(NTHREADS, 2) fwd_megakernel(Params p_unused) {
    extern __shared__ __attribute__((aligned(16))) unsigned char lds[];
    PP p = (PP)__builtin_amdgcn_kernarg_segment_ptr(); LAUNDER();
    { volatile LAS unsigned* misc = (volatile LAS unsigned*)((LAS unsigned char*)lds + LDS_BYTES - 64); if (otid() < 16) misc[otid()] = 0u; __syncthreads(); }
    (void)xcd_barrier_post((unsigned*)(p->ws + WS_BAR), (volatile LAS unsigned*)((LAS unsigned char*)lds + LDS_BYTES - 64));
    if (gridDim.x == 0xffffffffu) cg::this_grid().sync();
#define WLP(off) ((const pg8::bf16_t*)(p->ws + WS_W) + (size_t)layer * W_LAYER_ELEMS + (off))
#define HP ((pg8::bf16_t*)(p->ws + WS_H) + (size_t)256 * DM)
#define LDSL ((PG8_LAS unsigned char*)lds)
#define GBAR() do { XcdBarrier xb_; xb_.bar = (unsigned*)(p->ws + WS_BAR); xb_.x = xb_xcc_id(); xb_.st = (volatile LAS unsigned*)((LAS unsigned char*)lds + LDS_BYTES - 64); xcd_barrier(xb_); } while (0)
#ifdef REP_SYNC
#define SYNC() do { GBAR(); GBAR(); GBAR(); LAUNDER(); } while (0)
#elif defined(CG_SYNC)
#define SYNC() do { cg::this_grid().sync(); LAUNDER(); } while (0)
#else
#define SYNC() do { GBAR(); LAUNDER(); } while (0)
#endif
#if defined(DIAG) && DIAG == 3
#define STAMP(k) do { if (layer == 1 && obid() == 0 && otid() == 0) ((unsigned long long*)(p->ws + WS_DIAG + 64))[k] = __builtin_amdgcn_s_memrealtime(); } while (0)
#else
#define STAMP(k) do {} while (0)
#endif
#ifdef DIAG
    if (obid() == 0 && otid() < 8) ((float*)(p->ws + WS_DIAG))[otid()] = 0.f;
#endif
#ifndef SK_S0
    phase_s0(p, lds);
#ifdef REP_S0
    LAUNDER(); __syncthreads(); phase_s0(p, lds);
#endif
#endif
    SYNC();
#if defined(DIAG) && DIAG == 6
    diag_ada(p, lds); LAUNDER(); SYNC();
#endif
#pragma nounroll
    for (int layer = 0; layer < DEPTH; ++layer) {
        STAMP(0);
#ifndef SK_NORM
        phase_norm(p, layer, 0);
#ifdef REP_NORM
        LAUNDER(); phase_norm(p, layer, 0);
#endif
#endif
        SYNC(); STAMP(1);
#ifndef SK_Z
        { pg8::Gemm g{HP, WLP(WO_IN), MT, INP, DM, 0}; pg8::StaticOrder S; S.init(MT, INP, (int)gridDim.x, obid());
          pg8::EpiBf16g E{(pg8::bf16_t*)(p->ws + WS_Z), (size_t)INP, 1.f, 30, 0};
          pg8::gemm_phase<pg8::EpiBf16g, pg8::StaticOrder, true, true>(LDSL, g, S, E);
#ifdef REP_Z
          LAUNDER(); pg8::gemm_phase<pg8::EpiBf16g, pg8::StaticOrder, true, true>(LDSL, g, S, E);
#endif
        }
#endif
        SYNC(); STAMP(2);
#if defined(DIAG) && DIAG == 4
        if (layer == 0) { diag_z(p, lds); LAUNDER(); }
#endif
#ifndef SK_PREP
        phase_prep(p, layer);
#ifdef REP_PREP
        LAUNDER(); phase_prep(p, layer);
#endif
#endif
        LAUNDER(); STAMP(3);
#ifndef SK_GKV
        phase_gla_kv(p, layer, lds);
#ifdef REP_GKV
        LAUNDER(); phase_gla_kv(p, layer, lds);
#endif
#endif
        SYNC(); STAMP(4);
#if defined(DIAG) && DIAG == 7
        if (layer == 0) { diag_pool(p, lds); LAUNDER(); SYNC(); }
#endif
#ifndef SK_S4
#ifdef REP_S4
#pragma nounroll
        for (int rep_ = 0; rep_ < 2; ++rep_)
#endif
        {
        { pg8::Gemm g{(const pg8::bf16_t*)(p->ws + WS_AKV), WLP(WO_KN), MT, 512, 256, 0}; asm volatile("" : "+s"(g.K)); pg8::StaticOrder S; S.init(MT, 512, (int)gridDim.x, obid());
          pg8::EpiBf16g E{(pg8::bf16_t*)(p->ws + WS_K), (size_t)768, 1.f, 6, 96};
          pg8::gemm_phase<pg8::EpiBf16g, pg8::StaticOrder, true, true>(LDSL, g, S, E); }
        LAUNDER(); __builtin_amdgcn_sched_barrier(0);
        { pg8::Gemm g{WLP(WO_V), (const pg8::bf16_t*)(p->ws + WS_AKV), 512, MT, 256, 0}; asm volatile("" : "+s"(g.K)); pg8::StaticOrder S; S.init(512, MT, (int)gridDim.x, obid());
          pg8::EpiBf16g E{(pg8::bf16_t*)(p->ws + WS_VT), (size_t)MT, 1.f, 30, 0};
          pg8::gemm_phase<pg8::EpiBf16g, pg8::StaticOrder, true, true>(LDSL, g, S, E); }
        LAUNDER(); __builtin_amdgcn_sched_barrier(0);
        { pg8::Gemm g{(const pg8::bf16_t*)(p->ws + WS_AQ), WLP(WO_UQ), MT, 768, 256, 0}; asm volatile("" : "+s"(g.K)); pg8::StaticOrder S; S.init(MT, 768, (int)gridDim.x, obid());
          pg8::EpiBf16g E{(pg8::bf16_t*)(p->ws + WS_Q), (size_t)768, 0.10206207261596575f * 1.4426950408889634f, 30, 0};
          pg8::gemm_phase<pg8::EpiBf16g, pg8::StaticOrder, true, true>(LDSL, g, S, E); }
        LAUNDER(); __builtin_amdgcn_sched_barrier(0);
        }
#endif
        STAMP(5);
#ifndef SK_GSCAN
        phase_gla_scan(p);
#endif
#ifdef REP_SCAN
        SYNC(); phase_gla_kv(p, layer, lds); SYNC(); phase_gla_scan(p);
#endif
        SYNC(); STAMP(6);
#ifndef SK_ATTN
        phase_attn(p, layer, lds);
#ifdef REP_ATTN
        LAUNDER(); phase_attn(p, layer, lds);
#endif
#endif
        LAUNDER(); STAMP(7);
#ifndef SK_GOUT
        phase_gla_out(p, layer, lds);
#ifdef REP_GOUT
        LAUNDER(); phase_gla_out(p, layer, lds);
#endif
#endif
        SYNC(); STAMP(8);
#if defined(DIAG) && DIAG == 2
        if (layer == DIAG_LAYER) { diag_attn(p, layer, lds); LAUNDER(); }
#endif
#ifndef SK_WO
        { pg8::Gemm g{HP, WLP(WO_O), MT, DM, DM, 0}; pg8::StaticOrder S; const int lastl = (layer == DEPTH - 1); S.init(lastl ? NB * SEQ : MT, DM, (int)gridDim.x, obid(), lastl);
          const float* adal = (const float*)(p->ws + WS_ADAL) + (size_t)layer * NB * 6144; const float* adac = (const float*)(p->ws + WS_ADAC) + (size_t)layer * 6144;
          pg8::EpiResid E{layer == 0 ? p->ctx : (const float*)(p->ws + WS_XC), layer == 0 ? p->x : (const float*)p->out, (float*)(p->ws + WS_XC), p->out, adac + 2 * DM, adal + 2 * DM};
          pg8::gemm_phase<pg8::EpiResid, pg8::StaticOrder, false, true>(LDSL, g, S, E); }
#endif
        SYNC(); STAMP(9);
#if defined(DIAG) && DIAG == 5
        if (layer == 0) { diag_wo(p, lds); LAUNDER(); SYNC(); }
#endif
#ifndef SK_NORM
        phase_norm(p, layer, 1);
#endif
        SYNC(); STAMP(10);
#ifndef SK_UP
        { pg8::Gemm g{HP - DM, WLP(WO_UP), 281 * 256, 2 * DFF, DM, 2}; pg8::StaticOrder S; S.init(281 * 256, 2 * DFF, (int)gridDim.x, obid());
          pg8::EpiUp E{(pg8::bf16_t*)(p->ws + WS_AFF), p->conv_w + (size_t)layer * 3 * DFF, p->conv_b + (size_t)layer * DFF, MT};
          pg8::gemm_phase<pg8::EpiUp, pg8::StaticOrder, true, true>(LDSL, g, S, E);
#ifdef REP_UP
          LAUNDER(); pg8::gemm_phase<pg8::EpiUp, pg8::StaticOrder, true, true>(LDSL, g, S, E);
#endif
        }
#endif
        SYNC(); STAMP(11);
#if defined(DIAG) && DIAG == 1
        if (layer == 0) { diag_ffn_up(p, layer, lds); LAUNDER(); }
#endif
#if defined(DIAG) && DIAG == 8
        if (layer == DIAG_LAYER) { diag_down_a(p, layer); LAUNDER(); SYNC(); }
#endif
#ifndef SK_DN
        { pg8::Gemm g{(const pg8::bf16_t*)(p->ws + WS_AFF), WLP(WO_DN), MT, DM, DFF, 0}; pg8::StaticOrder S; const int lastl = (layer == DEPTH - 1); S.init(lastl ? NB * SEQ : MT, DM, (int)gridDim.x, obid(), lastl);
          const float* adal = (const float*)(p->ws + WS_ADAL) + (size_t)layer * NB * 6144; const float* adac = (const float*)(p->ws + WS_ADAC) + (size_t)layer * 6144;
          pg8::EpiResid E{(const float*)(p->ws + WS_XC), (const float*)p->out, (float*)(p->ws + WS_XC), p->out, adac + 5 * DM, adal + 5 * DM};
          pg8::gemm_phase<pg8::EpiResid, pg8::StaticOrder, false, true>(LDSL, g, S, E); }
#endif
        SYNC(); STAMP(12);
#if defined(DIAG) && DIAG == 8
        if (layer == DIAG_LAYER) { diag_down_b(p, lds); LAUNDER(); SYNC(); }
#endif
    }
    phase_final(p);
#ifdef DIAG
    SYNC();
    { const float* dg = (const float*)(p->ws + WS_DIAG); float d = dg[0] / (dg[1] + 1e-30f); d = exp2f(rintf(log2f(d + 1e-12f) * 2.f) * 0.5f); float v = 1000.f * sqrtf(d);
#if DIAG == 3
      const unsigned long long* ts = (const unsigned long long*)(p->ws + WS_DIAG + 64); v = (float)(ts[DIAG_TA1] - ts[DIAG_TA0]) * 0.0001f; const float vb = (float)(ts[DIAG_TB1] - ts[DIAG_TB0]) * 0.01f;
#endif
      for (size_t i = (size_t)obid() * NTHREADS + otid(); i < (size_t)NB * SEQ * DM; i += (size_t)gridDim.x * NTHREADS) p->out[i] = v;
#if DIAG == 3
      SYNC(); if (obid() == 0 && otid() == 0) p->out[0] = vb;
#endif
    }
#endif
}

extern "C" void kernel_launch(void* const* d_in, const int* in_sizes, int n_in, void* d_out, int out_size, void* d_ws, size_t ws_size, hipStream_t stream) {
    static int grid_blocks = 0;
    if (grid_blocks == 0) {
        if (n_in != 26 || ws_size < WS_END) { fprintf(stderr, "kernel_launch: unexpected n_in %d / ws %zu (need %zu)\n", n_in, ws_size, (size_t)WS_END); grid_blocks = -1; return; }
        int dev = 0, cus = 0, per_cu = 0;
        hipGetDevice(&dev); hipDeviceGetAttribute(&cus, hipDeviceAttributeMultiprocessorCount, dev);
        if (hipFuncSetAttribute((const void*)fwd_megakernel, hipFuncAttributeMaxDynamicSharedMemorySize, LDS_BYTES) != hipSuccess) { fprintf(stderr, "kernel_launch: hipFuncSetAttribute failed\n"); grid_blocks = -1; return; }
        if (hipOccupancyMaxActiveBlocksPerMultiprocessor(&per_cu, (const void*)fwd_megakernel, NTHREADS, LDS_BYTES) != hipSuccess || per_cu < 1) { fprintf(stderr, "kernel_launch: occupancy query gave %d\n", per_cu); per_cu = 1; }
        (void)hipGetLastError();
        grid_blocks = cus * per_cu;
    }
    if (grid_blocks < 0) return;
    Params p{};
    const float** pp = (const float**)&p;
    for (int i = 0; i < 26; ++i) pp[i] = (const float*)d_in[i];
    p.out = (float*)d_out; p.ws = (unsigned char*)d_ws;
    if (hipMemsetAsync((unsigned char*)d_ws + WS_BAR, 0, 16384, stream) != hipSuccess) { fprintf(stderr, "kernel_launch: memset failed\n"); return; }
    void* args[] = {&p};
    hipError_t e = hipLaunchCooperativeKernel((const void*)fwd_megakernel, dim3(grid_blocks), dim3(NTHREADS), args, LDS_BYTES, stream);
    if (e != hipSuccess) fprintf(stderr, "cooperative launch failed: %s (grid %d)\n", hipGetErrorString(e), grid_blocks);
}
```
